# Optimizing an MI355X kernel written in HIP

```python
import math
import jax
import jax.numpy as jnp
from jax import lax
import numpy as np


D_MODEL = 1024
BATCH = 16
SEQ = 4096
DEPTH = 2

N_EVEN = (DEPTH + 1) // 2
N_ODD = DEPTH // 2
N_DIR = 2
EPS = 1e-6
CONV_W = 4

SSD_WIDTH = D_MODEL
SSD_HEADDIM = 64
SSD_HEADS = SSD_WIDTH // SSD_HEADDIM
SSD_GROUPS = 4
SSD_HPG = SSD_HEADS // SSD_GROUPS
SSD_STATE = 128
SSD_XBC = SSD_WIDTH + 2 * SSD_GROUPS * SSD_STATE
SSD_CHUNK = 64

LRU_WIDTH = D_MODEL
LRU_BLOCKS = 16
LRU_BLOCK = LRU_WIDTH // LRU_BLOCKS
LRU_C = 8.0

CONV_CH = SSD_XBC + LRU_WIDTH
EVEN_IN = CONV_CH + SSD_WIDTH + LRU_WIDTH + N_DIR * SSD_HEADS
EVEN_MIX = SSD_WIDTH + LRU_WIDTH

HGRN_WIDTH = D_MODEL
HGRN_HEADDIM = 128
HGRN_HEADS = HGRN_WIDTH // HGRN_HEADDIM
HGRN_CHUNK = 32
HGRN_SCALE = HGRN_HEADDIM ** -0.5
ODD_IN = 5 * HGRN_WIDTH

D_FF = 4 * D_MODEL

kernel_name = 'hybrid_ssd_rglru_hgrn2_encoder'


def rmsnorm(u, g):
    uf = u.astype(jnp.float32)
    uf = uf * lax.rsqrt(jnp.mean(uf * uf, axis=-1, keepdims=True) + EPS)
    return (uf * g.astype(jnp.float32)).astype(u.dtype)


def centred_conv(u, w, b):
    s_ = u.shape[1]
    pad_l = (CONV_W - 1) // 2
    up = jnp.pad(u, ((0, 0), (pad_l, CONV_W - 1 - pad_l), (0, 0)))
    out = b
    for k in range(CONV_W):
        out = out + up[:, k:k + s_] * w[k]
    return out


def dir_stack(u_f, u_b):
    return jnp.stack([u_f, jnp.flip(u_b, axis=1)], axis=0)


def two_dir(u):
    return dir_stack(u, u)


def merge_dir(y):
    return y[0] + jnp.flip(y[1], axis=1)


def linear_scan(a, b):
    def step(h, ab):
        h = ab[0] * h + ab[1]
        return h, h
    h0 = jnp.zeros_like(a[:, :, 0])
    _, h = lax.scan(step, h0, (jnp.moveaxis(a, 2, 0), jnp.moveaxis(b, 2, 0)))
    return jnp.moveaxis(h, 0, 2)


def ssd_chunked(x, dt, a, bm, cm):
    r_, b_, s_ = x.shape[:3]
    n_chunks = s_ // SSD_CHUNK

    def chunks(u):
        u = u.reshape(r_, b_, n_chunks, SSD_CHUNK, *u.shape[3:])
        return jnp.moveaxis(u, 2, 0)

    xdt = (x * dt[..., None]).reshape(r_, b_, s_, SSD_GROUPS, SSD_HPG, SSD_HEADDIM)
    da = (dt * a[:, None, None, :]).reshape(r_, b_, s_, SSD_GROUPS, SSD_HPG)
    mask = jnp.tril(jnp.ones((SSD_CHUNK, SSD_CHUNK), dtype=bool))[:, :, None, None]

    def step(state, inp):
        xc, dac, bc, cc = inp
        cum = jnp.cumsum(dac, axis=2)
        seg = cum[:, :, :, None] - cum[:, :, None, :]
        decay = jnp.exp(jnp.where(mask, seg, -jnp.inf))
        cb = jnp.einsum('rbtgn,rbsgn->rbtsg', cc, bc)
        y_in = jnp.einsum('rbtsg,rbtsge,rbsgep->rbtgep', cb, decay, xc)
        y_st = jnp.einsum('rbtgn,rbgepn->rbtgep', cc, state) * jnp.exp(cum)[..., None]
        last = cum[:, :, -1]
        w_s = jnp.exp(last[:, :, None] - cum)
        state = state * jnp.exp(last)[..., None, None] + jnp.einsum(
            'rbsgn,rbsge,rbsgep->rbgepn', bc, w_s, xc)
        return state, y_in + y_st

    state0 = jnp.zeros((r_, b_, SSD_GROUPS, SSD_HPG, SSD_HEADDIM, SSD_STATE), jnp.float32)
    _, y = lax.scan(step, state0, (chunks(xdt), chunks(da), chunks(bm), chunks(cm)))
    return jnp.moveaxis(y, 0, 2).reshape(r_, b_, s_, SSD_HEADS, SSD_HEADDIM)


def gla_chunked(q, k, v, log_f):
    r_, b_, s_ = q.shape[:3]
    n_chunks = s_ // HGRN_CHUNK

    def chunks(u):
        u = u.reshape(r_, b_, n_chunks, HGRN_CHUNK, *u.shape[3:])
        return jnp.moveaxis(u, 2, 0)

    mask = jnp.tril(jnp.ones((HGRN_CHUNK, HGRN_CHUNK), dtype=bool))

    def step(state, inp):
        qc, kc, vc, gc = inp
        bcum = jnp.cumsum(gc, axis=2)
        q_t = qc * jnp.exp(bcum)
        k_t = kc * jnp.exp(-bcum)
        att = jnp.where(mask, jnp.einsum('rbthk,rbshk->rbhts', q_t, k_t), 0.0)
        y = jnp.einsum('rbhts,rbshv->rbthv', att, vc) + jnp.einsum(
            'rbthk,rbhkv->rbthv', q_t, state)
        last = bcum[:, :, -1]
        state = state * jnp.exp(last)[..., None] + jnp.einsum(
            'rbshk,rbshv->rbhkv', kc * jnp.exp(last[:, :, None] - bcum), vc)
        return state, y

    state0 = jnp.zeros((r_, b_, HGRN_HEADS, HGRN_HEADDIM, HGRN_HEADDIM), jnp.float32)
    _, y = lax.scan(step, state0, (chunks(q), chunks(k), chunks(v), chunks(log_f)))
    return jnp.moveaxis(y, 0, 2).reshape(r_, b_, s_, HGRN_HEADS, HGRN_HEADDIM)


def mamba2_mixer(xbc, z, dt_raw, a_log, dt_bias, d_skip, norm_w):
    f32 = jnp.float32
    b_, s_, _ = xbc.shape
    xbc = xbc.astype(f32)
    xs = xbc[..., :SSD_WIDTH].reshape(b_, s_, SSD_HEADS, SSD_HEADDIM)
    bm = xbc[..., SSD_WIDTH:SSD_WIDTH + SSD_GROUPS * SSD_STATE].reshape(b_, s_, SSD_GROUPS, SSD_STATE)
    cm = xbc[..., SSD_WIDTH + SSD_GROUPS * SSD_STATE:].reshape(b_, s_, SSD_GROUPS, SSD_STATE)
    dt = jax.nn.softplus(dt_raw.astype(f32) + dt_bias.astype(f32))
    dtd = dir_stack(dt[:, :, 0], dt[:, :, 1])
    a = -jnp.exp(a_log.astype(f32))
    y = merge_dir(ssd_chunked(two_dir(xs), dtd, a, two_dir(bm), two_dir(cm)))
    y = (y + d_skip.astype(f32)[:, None] * xs).reshape(b_, s_, SSD_WIDTH)
    u = (y * jax.nn.silu(z.astype(f32))).reshape(b_, s_, SSD_GROUPS, SSD_WIDTH // SSD_GROUPS)
    u = u * lax.rsqrt(jnp.mean(u * u, axis=-1, keepdims=True) + EPS)
    return u.reshape(b_, s_, SSD_WIDTH) * norm_w.astype(f32)


def rglru_mixer(u, gate, w_a, b_a, w_x, b_x, lam):
    f32 = jnp.float32
    b_, s_, _ = u.shape
    ud = two_dir(u.astype(f32))
    ub = ud.reshape(N_DIR, b_, s_, LRU_BLOCKS, LRU_BLOCK)
    r_gate = jax.nn.sigmoid(jnp.einsum('rbsnc,rncd->rbsnd', ub, w_a.astype(f32)).reshape(
        N_DIR, b_, s_, LRU_WIDTH) + b_a.astype(f32)[:, None, None])
    i_gate = jax.nn.sigmoid(jnp.einsum('rbsnc,rncd->rbsnd', ub, w_x.astype(f32)).reshape(
        N_DIR, b_, s_, LRU_WIDTH) + b_x.astype(f32)[:, None, None])
    log_a = -LRU_C * r_gate * jax.nn.softplus(-lam.astype(f32))[:, None, None]
    inp = jnp.sqrt(-jnp.expm1(2.0 * log_a)) * (i_gate * ud)
    h = merge_dir(linear_scan(jnp.exp(log_a), inp))
    return h * jax.nn.gelu(gate.astype(f32))


def hgrn2_mixer(q, f_raw, inp, gate, lb, norm_w):
    f32 = jnp.float32
    b_, s_, _ = q.shape
    f_raw = f_raw.astype(f32)
    lb = lb.astype(f32)
    log_f = jnp.logaddexp(jnp.log(lb), jnp.log1p(-lb) + jax.nn.log_sigmoid(f_raw))
    k = (1.0 - lb) * jax.nn.sigmoid(-f_raw)

    def heads(u):
        return u.reshape(N_DIR, b_, s_, HGRN_HEADS, HGRN_HEADDIM)

    qd = heads(two_dir(q.astype(f32) * HGRN_SCALE))
    kd = heads(dir_stack(k[:, :, 0], k[:, :, 1]))
    gd = heads(dir_stack(log_f[:, :, 0], log_f[:, :, 1]))
    vd = heads(two_dir(inp.astype(f32)))
    o = merge_dir(gla_chunked(qd, kd, vd, gd))
    o = o * lax.rsqrt(jnp.mean(o * o, axis=-1, keepdims=True) + EPS)
    o = o * norm_w.astype(f32).reshape(HGRN_HEADS, HGRN_HEADDIM)
    return o.reshape(b_, s_, HGRN_WIDTH) * jax.nn.silu(gate.astype(f32))


def setup_inputs(seed: int = 0) -> dict:
    key = jax.random.key(seed)
    ks = jax.random.split(key, 24)
    f32 = jnp.float32

    def nrm(k, shape, scale):
        return jax.random.normal(k, shape, f32) * scale

    x = nrm(ks[0], (BATCH, SEQ, D_MODEL), 1.0)
    even_w_in = nrm(ks[1], (N_EVEN, D_MODEL, EVEN_IN), D_MODEL ** -0.5)
    even_conv_w = nrm(ks[2], (N_EVEN, CONV_W, CONV_CH), CONV_W ** -0.5)
    even_conv_b = nrm(ks[3], (N_EVEN, CONV_CH), 0.01)
    ssd_a_log = jnp.log(jax.random.uniform(ks[4], (N_EVEN, N_DIR, SSD_HEADS), f32, 1.0, 16.0))
    dt0 = jnp.exp(jax.random.uniform(ks[5], (N_EVEN, N_DIR, SSD_HEADS), f32,
                                     math.log(1e-3), math.log(1e-1)))
    ssd_dt_bias = dt0 + jnp.log(-jnp.expm1(-dt0))
    ssd_d = 1.0 + nrm(ks[6], (N_EVEN, SSD_HEADS), 0.1)
    ssd_norm_w = 1.0 + nrm(ks[7], (N_EVEN, SSD_WIDTH), 0.1)
    lru_w_a = nrm(ks[8], (N_EVEN, N_DIR, LRU_BLOCKS, LRU_BLOCK, LRU_BLOCK), LRU_BLOCK ** -0.5)
    lru_b_a = nrm(ks[9], (N_EVEN, N_DIR, LRU_WIDTH), 0.01)
    lru_w_x = nrm(ks[10], (N_EVEN, N_DIR, LRU_BLOCKS, LRU_BLOCK, LRU_BLOCK), LRU_BLOCK ** -0.5)
    lru_b_x = nrm(ks[11], (N_EVEN, N_DIR, LRU_WIDTH), 0.01)
    a0 = jax.random.uniform(ks[12], (N_EVEN, N_DIR, LRU_WIDTH), f32, 0.9, 0.999)
    p0 = a0 ** (1.0 / LRU_C)
    lru_lambda = jnp.log(p0) - jnp.log1p(-p0)
    even_w_out = nrm(ks[13], (N_EVEN, EVEN_MIX, D_MODEL), EVEN_MIX ** -0.5)
    odd_w_in = nrm(ks[14], (N_ODD, D_MODEL, ODD_IN), D_MODEL ** -0.5)
    hgrn_lb_logits = nrm(ks[15], (DEPTH, HGRN_WIDTH), 0.1)
    hgrn_norm_w = 1.0 + nrm(ks[16], (N_ODD, HGRN_WIDTH), 0.1)
    odd_w_out = nrm(ks[17], (N_ODD, HGRN_WIDTH, D_MODEL), HGRN_WIDTH ** -0.5)
    norm_mix = 1.0 + nrm(ks[18], (DEPTH, D_MODEL), 0.1)
    norm_mlp = 1.0 + nrm(ks[19], (DEPTH, D_MODEL), 0.1)
    mlp_w1 = nrm(ks[20], (DEPTH, D_MODEL, D_FF), D_MODEL ** -0.5)
    mlp_w2 = nrm(ks[21], (DEPTH, D_FF, D_MODEL), D_FF ** -0.5)
    norm_final = 1.0 + nrm(ks[22], (D_MODEL,), 0.1)
    return {'x': x, 'even_w_in': even_w_in, 'even_conv_w': even_conv_w,
            'even_conv_b': even_conv_b, 'ssd_a_log': ssd_a_log, 'ssd_dt_bias': ssd_dt_bias,
            'ssd_d': ssd_d, 'ssd_norm_w': ssd_norm_w, 'lru_w_a': lru_w_a, 'lru_b_a': lru_b_a,
            'lru_w_x': lru_w_x, 'lru_b_x': lru_b_x, 'lru_lambda': lru_lambda,
            'even_w_out': even_w_out, 'odd_w_in': odd_w_in, 'hgrn_lb_logits': hgrn_lb_logits,
            'hgrn_norm_w': hgrn_norm_w, 'odd_w_out': odd_w_out, 'norm_mix': norm_mix,
            'norm_mlp': norm_mlp, 'mlp_w1': mlp_w1, 'mlp_w2': mlp_w2, 'norm_final': norm_final}


def reference(x, even_w_in, even_conv_w, even_conv_b, ssd_a_log, ssd_dt_bias, ssd_d,
              ssd_norm_w, lru_w_a, lru_b_a, lru_w_x, lru_b_x, lru_lambda, even_w_out,
              odd_w_in, hgrn_lb_logits, hgrn_norm_w, odd_w_out, norm_mix, norm_mlp,
              mlp_w1, mlp_w2, norm_final):
    b_, s_, _ = x.shape
    p_lb = jax.nn.softmax(hgrn_lb_logits.astype(jnp.float32), axis=0)
    lb_all = jnp.cumsum(p_lb, axis=0) - p_lb[0]
    for l in range(DEPTH):
        h = rmsnorm(x, norm_mix[l])
        if l % 2 == 0:
            j = l // 2
            proj = h @ even_w_in[j]
            conv = centred_conv(proj[..., :CONV_CH], even_conv_w[j], even_conv_b[j])
            xbc = jax.nn.silu(conv[..., :SSD_XBC])
            u_lru = conv[..., SSD_XBC:]
            o0 = CONV_CH
            z = proj[..., o0:o0 + SSD_WIDTH]
            g_lru = proj[..., o0 + SSD_WIDTH:o0 + SSD_WIDTH + LRU_WIDTH]
            dt_raw = proj[..., o0 + SSD_WIDTH + LRU_WIDTH:].reshape(b_, s_, N_DIR, SSD_HEADS)
            y_a = mamba2_mixer(xbc, z, dt_raw, ssd_a_log[j], ssd_dt_bias[j], ssd_d[j],
                               ssd_norm_w[j])
            y_b = rglru_mixer(u_lru, g_lru, lru_w_a[j], lru_b_a[j], lru_w_x[j], lru_b_x[j],
                              lru_lambda[j])
            mix = jnp.concatenate([y_a, y_b], axis=-1) @ even_w_out[j]
        else:
            j = l // 2
            proj = h @ odd_w_in[j]
            w_ = HGRN_WIDTH
            q = proj[..., :w_]
            f_raw = proj[..., w_:3 * w_].reshape(b_, s_, N_DIR, w_)
            inp = proj[..., 3 * w_:4 * w_]
            gate = proj[..., 4 * w_:]
            mix = hgrn2_mixer(q, f_raw, inp, gate, lb_all[l], hgrn_norm_w[j]) @ odd_w_out[j]
        x = x + mix.astype(x.dtype)
        h = rmsnorm(x, norm_mlp[l])
        x = x + (jnp.square(jax.nn.relu(h @ mlp_w1[l])) @ mlp_w2[l]).astype(x.dtype)
    return rmsnorm(x, norm_final)
```

```cpp
#include <hip/hip_runtime.h>
#include <hip/hip_cooperative_groups.h>
#include <cstdio>
namespace cg = cooperative_groups;

#ifndef GEMM_STAGGER
#define GEMM_STAGGER 0
#endif
#ifndef TR_GATHER
#define TR_GATHER 0
#endif
#define LAS __attribute__((address_space(3)))
typedef unsigned short u16;
typedef short bf16x8 __attribute__((ext_vector_type(8)));
typedef float f32x4 __attribute__((ext_vector_type(4)));
typedef float f32x2 __attribute__((ext_vector_type(2)));
typedef unsigned u32x4 __attribute__((ext_vector_type(4)));
typedef unsigned u32x2 __attribute__((ext_vector_type(2)));

constexpr int NTOK = 65536, DM = 1024, SEQ = 4096;
constexpr int PLD = 5120;
constexpr int LDS_BYTES = 131072 + 16;
constexpr float EPS = 1e-6f;

constexpr size_t WS_WIN0 = 0;
constexpr size_t WS_WOUT0 = WS_WIN0 + (size_t)5376 * 1024 * 2;
constexpr size_t WS_WUP0 = WS_WOUT0 + (size_t)1024 * 2048 * 2;
constexpr size_t WS_WUP1 = WS_WUP0 + (size_t)4096 * 1024 * 2;
constexpr size_t WS_WDN0 = WS_WUP1 + (size_t)4096 * 1024 * 2;
constexpr size_t WS_WDN1 = WS_WDN0 + (size_t)4096 * 1024 * 2;
constexpr size_t WS_WIN1 = WS_WDN1 + (size_t)4096 * 1024 * 2;
constexpr size_t WS_WOUT1 = WS_WIN1 + (size_t)5120 * 1024 * 2;
constexpr size_t WS_SS = WS_WOUT1 + (size_t)1024 * 1024 * 2;
constexpr size_t WS_DT = WS_SS + (size_t)5 * NTOK * 4;
constexpr size_t WS_XB = WS_DT + (size_t)NTOK * 32 * 4;
constexpr size_t WS_TMP2 = WS_XB + (size_t)NTOK * 1024 * 2;
constexpr size_t WS_PROJ = WS_TMP2 + (size_t)NTOK * 1024 * 2;
constexpr size_t WS_BAR = WS_PROJ + (size_t)NTOK * PLD * 2;
constexpr size_t WS_SSP = WS_BAR + 16384;
constexpr size_t WS_HALO = WS_SSP + (size_t)4 * NTOK * 16 * 4;
constexpr size_t WS_END = WS_HALO + (size_t)16 * 64 * 384 * 48;

struct Args { const float* in[23]; float* out; unsigned char* ws; int lo, hi, probe, pad; };

__device__ __forceinline__ float bf_lo(unsigned w) { return __uint_as_float(w << 16); }
__device__ __forceinline__ float bf_hi(unsigned w) { return __uint_as_float(w & 0xffff0000u); }
__device__ __forceinline__ float bf2f(u16 b) { return __uint_as_float(((unsigned)b) << 16); }
__device__ __forceinline__ u16 f2bf(float f) { unsigned u = __float_as_uint(f); u += 0x7FFFu + ((u >> 16) & 1u); return (u16)(u >> 16); }
typedef __bf16 bf16x2_t __attribute__((ext_vector_type(2)));
__device__ __forceinline__ unsigned pk2(float lo, float hi) { const f32x2 v = (f32x2){lo, hi}; const bf16x2_t b = __builtin_convertvector(v, bf16x2_t); return __builtin_bit_cast(unsigned, b); }
__device__ __forceinline__ void unpack8(const u32x4 v, float* f) { f[0] = bf_lo(v.x); f[1] = bf_hi(v.x); f[2] = bf_lo(v.y); f[3] = bf_hi(v.y); f[4] = bf_lo(v.z); f[5] = bf_hi(v.z); f[6] = bf_lo(v.w); f[7] = bf_hi(v.w); }
__device__ __forceinline__ u32x4 pack8(const float* f) { u32x4 w; w.x = pk2(f[0], f[1]); w.y = pk2(f[2], f[3]); w.z = pk2(f[4], f[5]); w.w = pk2(f[6], f[7]); return w; }
__device__ __forceinline__ float sigmoidf_(float x) { return __builtin_amdgcn_rcpf(1.0f + __expf(-x)); }
__device__ __forceinline__ float siluf_(float x) { return x * __builtin_amdgcn_rcpf(1.0f + __expf(-x)); }
__device__ __forceinline__ float gelu_tanh(float x) { const float v = 0.7978845608028654f * (x + 0.044715f * x * x * x); const float th = 1.0f - 2.0f * __builtin_amdgcn_rcpf(__expf(2.0f * v) + 1.0f); return 0.5f * x * (1.0f + th); }

namespace pg8 {
constexpr int BM = 256, BK = 64, HALF = 128, HTB = HALF * BK * 2, STAGE_BYTES = 8 * HTB, NXCD = 8, WGM = 8;
__host__ __device__ __forceinline__ int lds_byte(int r, int c) { const int st = (r >> 4) * 2 + (c >> 5), rr = r & 15, cc = c & 31, ob = rr * 64 + cc * 2; return st * 1024 + (ob ^ (((ob >> 9) & 1) << 5)); }
__host__ __device__ __forceinline__ void stage_rc(int b, int& R, int& C) { const int st = b / 1024, sb = b % 1024, swz = sb ^ (((sb >> 9) & 1) << 5); R = (st >> 1) * 16 + swz / 64; C = (st & 1) * 32 + (swz % 64) / 2; }
__host__ __device__ __forceinline__ int perm32(int rho) { const int n = rho >> 4, i = rho & 15; return 8 * (i >> 2) + 4 * n + (i & 3); }
struct Unit { int pm, pn; };
struct Gemm { const u16* A; const u16* Bt; int M, N, K, lda; };
struct StaticOrder {
    int nM, nN, nwg, G, c;
    __device__ void init(int M, int N, int G_, int c_) { nM = M / BM; nN = N / BM; nwg = nM * nN; G = G_; c = c_; }
    __device__ bool next(int i, Unit& u) const {
        const long L = (long)i * G + c; if (L >= nwg) return false;
        int wgid = (int)L; { const int q = nwg / NXCD, r = nwg % NXCD, xcd = wgid % NXCD, off = wgid / NXCD; wgid = (xcd < r ? xcd * (q + 1) : r * (q + 1) + (xcd - r) * q) + off; }
        const int nig = WGM * nN, gid = wgid / nig, fm = gid * WGM, gsz = (nM - fm) < WGM ? (nM - fm) : WGM;
        u.pm = fm + ((wgid % nig) % gsz); u.pn = (wgid % nig) / gsz; return true;
    }
};

template <int ACT, bool DT, int SLOTS> struct EpiScale {
    static constexpr bool PERM = true;
    u16* O; int ldc; const float* ss; float* dt;
    __device__ __forceinline__ void pre(const Unit&, int, int, float (&)[8]) const {}
    __device__ __forceinline__ void operator()(const f32x4 (&acc)[2][2][4][2], const Unit& u, int wr, int wc, int fr, int fq, const float (&)[8]) const {
        const int row0 = u.pm * BM + wr * 64 + fr;
        float ep[8];
#pragma unroll
        for (int ai = 0; ai < 2; ++ai)
#pragma unroll
            for (int m = 0; m < 4; ++m) { const int row = row0 + ai * HALF + m * 16;
                if (SLOTS == 1) ep[ai * 4 + m] = ss[row];
                else { const f32x4 pq = *(const f32x4*)(ss + (size_t)row * 16 + 4 * fq); ep[ai * 4 + m] = (pq[0] + pq[1]) + (pq[2] + pq[3]); } }
        if (SLOTS != 1) {
#pragma unroll
            for (int q = 0; q < 8; ++q) { ep[q] += __shfl_xor(ep[q], 16); ep[q] += __shfl_xor(ep[q], 32); } }
        if (DT && u.pn == 20) {
            if (wc == 0) {
#pragma unroll
                for (int ai = 0; ai < 2; ++ai)
#pragma unroll
                    for (int m = 0; m < 4; ++m) { const int row = row0 + ai * HALF + m * 16; const float rs = rsqrtf(ep[ai * 4 + m] * (1.0f / 1024.0f) + EPS);
                        *(f32x4*)(dt + (size_t)row * 32 + 8 * fq) = acc[ai][0][m][0] * rs; *(f32x4*)(dt + (size_t)row * 32 + 8 * fq + 4) = acc[ai][0][m][1] * rs; }
            }
            return;
        }
        const int col0 = u.pn * BM + wc * 32 + 8 * fq;
#pragma unroll
        for (int ai = 0; ai < 2; ++ai)
#pragma unroll
            for (int m = 0; m < 4; ++m) { const int row = row0 + ai * HALF + m * 16; const float rs = rsqrtf(ep[ai * 4 + m] * (1.0f / 1024.0f) + EPS);
                u16* rowp = O + (size_t)row * ldc + col0;
#pragma unroll
                for (int bj = 0; bj < 2; ++bj) { f32x4 v0 = acc[ai][bj][m][0] * rs, v1 = acc[ai][bj][m][1] * rs;
                    if (ACT == 1) {
#pragma unroll
                        for (int j = 0; j < 4; ++j) { const float a0 = fmaxf(v0[j], 0.f), a1 = fmaxf(v1[j], 0.f); v0[j] = a0 * a0; v1[j] = a1 * a1; } }
                    u32x4 w; w.x = pk2(v0[0], v0[1]); w.y = pk2(v0[2], v0[3]); w.z = pk2(v1[0], v1[1]); w.w = pk2(v1[2], v1[3]);
                    *(u32x4*)(rowp + bj * HALF) = w; } }
    }
};
template <bool LAST> struct EpiResid {
    static constexpr bool PERM = true;
    u16* xb; float* out; float* ss;
    __device__ __forceinline__ void pre(const Unit&, int, int, float (&)[8]) const {}
    __device__ __forceinline__ void operator()(const f32x4 (&acc)[2][2][4][2], const Unit& u, int wr, int wc, int fr, int fq, const float (&)[8]) const {
        const int row0 = u.pm * BM + wr * 64 + fr, col0 = u.pn * BM + wc * 32 + 8 * fq;
#pragma unroll
        for (int ai = 0; ai < 2; ++ai) {
            u32x4 bv[4][2];
#pragma unroll
            for (int m = 0; m < 4; ++m)
#pragma unroll
                for (int bj = 0; bj < 2; ++bj) bv[m][bj] = *(const u32x4*)(xb + (size_t)(row0 + ai * HALF + m * 16) * DM + col0 + bj * HALF);
#pragma unroll
            for (int m = 0; m < 4; ++m) { const int row = row0 + ai * HALF + m * 16; const size_t ro = (size_t)row * DM + col0; float s = 0.f;
#pragma unroll
                for (int bj = 0; bj < 2; ++bj) { float b8[8]; unpack8(bv[m][bj], b8);
                    const f32x4 v0 = (f32x4){b8[0], b8[1], b8[2], b8[3]} + acc[ai][bj][m][0], v1 = (f32x4){b8[4], b8[5], b8[6], b8[7]} + acc[ai][bj][m][1];
                    s += v0[0] * v0[0] + v0[1] * v0[1] + v0[2] * v0[2] + v0[3] * v0[3] + v1[0] * v1[0] + v1[1] * v1[1] + v1[2] * v1[2] + v1[3] * v1[3];
                    if (LAST) { *(f32x4*)(out + ro + bj * HALF) = v0; *(f32x4*)(out + ro + bj * HALF + 4) = v1; }
                    else { u32x4 w; w.x = pk2(v0[0], v0[1]); w.y = pk2(v0[2], v0[3]); w.z = pk2(v1[0], v1[1]); w.w = pk2(v1[2], v1[3]); *(u32x4*)(xb + ro + bj * HALF) = w; } }
                s += __shfl_xor(s, 16); s += __shfl_xor(s, 32);
                if (fq == 0) ss[(size_t)row * 16 + u.pn * 4 + wc] = s; }
        }
    }
};

template <class Epi>
__device__ __forceinline__ void gemm_phase(LAS unsigned char* lds, const Gemm g, const StaticOrder& S, const Epi& E) {
    const int tid = threadIdx.x, wid = __builtin_amdgcn_readfirstlane(tid >> 6), lane = tid & 63, wr = wid >> 2, wc = wid & 3, fr = lane & 15, fq = lane >> 4;
    const int K = g.K, nt = K / BK, lda = g.lda;
    unsigned voffA[2], voffB[2];
#pragma unroll
    for (int i = 0; i < 2; ++i) { int R, C; stage_rc(tid * 16 + i * 8192, R, C); const int Rb = Epi::PERM ? ((R & ~31) + perm32(R & 31)) : R;
        voffA[i] = (unsigned)(R * lda + C) * 2u; voffB[i] = (unsigned)(Rb * K + C) * 2u; }
    const size_t kstep = (size_t)(BK * 2);
    const size_t hstepA = (size_t)HALF * lda * 2, hstepB = (size_t)HALF * K * 2;
    const size_t tstepA = 2 * hstepA, tstepB = 2 * hstepB;
    const unsigned ldsw = (unsigned)wid * 1024u;
    const int aoff = lds_byte(wr * 64 + fr, fq * 8), boff = lds_byte(wc * 32 + fr, fq * 8);
#define PG8_SA(b, h) (((b) * 2 + (h)) * HTB)
#define PG8_SB(b, h) ((4 + (b) * 2 + (h)) * HTB)
#define PG8_STAGE(bufoff, gbase, voff) do { _Pragma("unroll") for (int _i = 0; _i < 2; ++_i) \
        __builtin_amdgcn_global_load_lds((const unsigned*)((const char*)(gbase) + (voff)[_i]), (LAS unsigned*)(lds + (bufoff) + ldsw + _i * 8192), 16, 0, 0); } while (0)
#define PG8_LDA(dst, b, h) do { _Pragma("unroll") for (int m = 0; m < 4; ++m) _Pragma("unroll") for (int k = 0; k < 2; ++k) dst[m][k] = *(const LAS bf16x8*)(lds + PG8_SA(b, h) + aoff + m * 2048 + k * 1024); } while (0)
#define PG8_LDB(dst, b, h) do { _Pragma("unroll") for (int n = 0; n < 2; ++n) _Pragma("unroll") for (int k = 0; k < 2; ++k) dst[n][k] = *(const LAS bf16x8*)(lds + PG8_SB(b, h) + boff + n * 2048 + k * 1024); } while (0)
#define PG8_MMA(ai, bj, At, Bt) do { __builtin_amdgcn_s_setprio(1); _Pragma("unroll") for (int m = 0; m < 4; ++m) _Pragma("unroll") for (int n = 0; n < 2; ++n) _Pragma("unroll") for (int k = 0; k < 2; ++k) \
        acc[ai][bj][m][n] = __builtin_amdgcn_mfma_f32_16x16x32_bf16(Bt[n][k], At[m][k], acc[ai][bj][m][n], 0, 0, 0); __builtin_amdgcn_s_setprio(0); } while (0)
#define PG8_WAIT_V(n) asm volatile("s_waitcnt vmcnt(" #n ")" ::: "memory")
#define PG8_WAIT_L(n) asm volatile("s_waitcnt lgkmcnt(" #n ")" ::: "memory")
#define PG8_BAR __builtin_amdgcn_s_barrier()
#define PG8_SCHED __builtin_amdgcn_sched_barrier(0)
    Unit cur, nxt; int ui = 0;
    if (!S.next(0, cur)) return;
#if GEMM_STAGGER
    for (int q_ = 0; q_ < ((S.c >> 3) & 3); ++q_) __builtin_amdgcn_s_sleep(100);
#endif
    f32x4 acc[2][2][4][2];
#pragma unroll
    for (int a = 0; a < 2; ++a)
#pragma unroll
        for (int b = 0; b < 2; ++b)
#pragma unroll
            for (int m = 0; m < 4; ++m)
#pragma unroll
                for (int n = 0; n < 2; ++n) acc[a][b][m][n] = (f32x4){0.f, 0.f, 0.f, 0.f};
    bf16x8 At[4][2], B0[2][2], B1[2][2]; float epre[8];
#pragma unroll
    for (int q_ = 0; q_ < 8; ++q_) epre[q_] = 0.f;
    const char* cA = (const char*)g.A + (size_t)cur.pm * tstepA; const char* cB = (const char*)g.Bt + (size_t)cur.pn * tstepB;
    PG8_STAGE(PG8_SB(0, 0), cB, voffB); PG8_STAGE(PG8_SA(0, 0), cA, voffA); PG8_STAGE(PG8_SB(0, 1), cB + hstepB, voffB); PG8_STAGE(PG8_SA(0, 1), cA + hstepA, voffA);
    if (wr == 1) PG8_BAR;
    PG8_WAIT_V(4); PG8_BAR;
    PG8_STAGE(PG8_SB(1, 0), cB + kstep, voffB); PG8_STAGE(PG8_SA(1, 0), cA + kstep, voffA); PG8_STAGE(PG8_SB(1, 1), cB + hstepB + kstep, voffB);
    PG8_WAIT_V(6); PG8_BAR;
    for (;;) {
        const bool has_next = S.next(ui + 1, nxt);
        const char* nA = has_next ? (const char*)g.A + (size_t)nxt.pm * tstepA : cA; const char* nB = has_next ? (const char*)g.Bt + (size_t)nxt.pn * tstepB : cB;
        for (int t = 0; t < nt; t += 2) {
            const bool last = (t == nt - 2);
            const char* a1 = cA + (size_t)(t + 1) * kstep;
            const char* a2 = last ? nA : cA + (size_t)(t + 2) * kstep; const char* b2 = last ? nB : cB + (size_t)(t + 2) * kstep;
            const char* a3 = a2 + kstep; const char* b3 = b2 + kstep;
            if (last) E.pre(cur, wr, fr, epre);
            PG8_LDB(B0, 0, 0); PG8_SCHED; PG8_LDA(At, 0, 0); PG8_STAGE(PG8_SA(1, 1), a1 + hstepA, voffA);
            PG8_WAIT_L(8); PG8_BAR; PG8_WAIT_L(0); PG8_MMA(0, 0, At, B0); PG8_BAR; PG8_SCHED;
            PG8_LDB(B1, 0, 1); PG8_STAGE(PG8_SB(0, 0), b2, voffB);
            PG8_BAR; PG8_WAIT_L(0); PG8_MMA(0, 1, At, B1); PG8_BAR;
            PG8_LDA(At, 0, 1); PG8_STAGE(PG8_SA(0, 0), a2, voffA);
            PG8_BAR; PG8_WAIT_L(0); PG8_MMA(1, 0, At, B0); PG8_BAR; PG8_SCHED;
            PG8_STAGE(PG8_SB(0, 1), b2 + hstepB, voffB);
            PG8_WAIT_V(6); PG8_BAR; PG8_MMA(1, 1, At, B1); PG8_BAR;
            PG8_LDB(B0, 1, 0); PG8_SCHED; PG8_LDA(At, 1, 0); PG8_STAGE(PG8_SA(0, 1), a2 + hstepA, voffA);
            PG8_WAIT_L(8); PG8_BAR; PG8_WAIT_L(0); PG8_MMA(0, 0, At, B0); PG8_BAR; PG8_SCHED;
            PG8_LDB(B1, 1, 1); PG8_STAGE(PG8_SB(1, 0), b3, voffB);
            PG8_BAR; PG8_WAIT_L(0); PG8_MMA(0, 1, At, B1); PG8_BAR;
            PG8_LDA(At, 1, 1); PG8_STAGE(PG8_SA(1, 0), a3, voffA);
            PG8_BAR; PG8_WAIT_L(0); PG8_MMA(1, 0, At, B0); PG8_BAR; PG8_SCHED;
            PG8_STAGE(PG8_SB(1, 1), b3 + hstepB, voffB);
            PG8_WAIT_V(6); PG8_BAR; PG8_MMA(1, 1, At, B1); PG8_BAR;
        }
        E(acc, cur, wr, wc, fr, fq, epre);
        if (!has_next) break;
#pragma unroll
        for (int a = 0; a < 2; ++a)
#pragma unroll
            for (int b = 0; b < 2; ++b)
#pragma unroll
                for (int m = 0; m < 4; ++m)
#pragma unroll
                    for (int n = 0; n < 2; ++n) acc[a][b][m][n] = (f32x4){0.f, 0.f, 0.f, 0.f};
        cur = nxt; cA = nA; cB = nB; ++ui;
    }
    PG8_WAIT_V(0);
    if (wr == 0) PG8_BAR;
    PG8_BAR;
#undef PG8_SA
#undef PG8_SB
#undef PG8_STAGE
#undef PG8_LDA
#undef PG8_LDB
#undef PG8_MMA
#undef PG8_WAIT_V
#undef PG8_WAIT_L
#undef PG8_BAR
#undef PG8_SCHED
}
}

__device__ __forceinline__ void transpose_job(const float* W, int K, int N, int Npad, u16* dst, const float* gain, u16* tile) {
    const int tid = threadIdx.x, kt = K / 64, ntiles = (Npad / 64) * kt;
    for (int t0 = blockIdx.x; t0 < ntiles; t0 += 2 * gridDim.x) {
        __syncthreads();
        f32x4 v[2][2]; float gk[2][2];
#pragma unroll
        for (int tt = 0; tt < 2; ++tt) { const int t = t0 + tt * gridDim.x; const bool ok = t < ntiles; const int k0 = ok ? (t % kt) * 64 : 0, n0 = ok ? (t / kt) * 64 : 0;
#pragma unroll
            for (int i = 0; i < 2; ++i) { const int k = (tid >> 4) + 32 * i, n = n0 + (tid & 15) * 4;
                v[tt][i] = (f32x4){0.f, 0.f, 0.f, 0.f}; if (ok && n < N) v[tt][i] = *(const f32x4*)(W + (size_t)(k0 + k) * N + n);
                gk[tt][i] = gain ? gain[k0 + k] : 1.0f; } }
#pragma unroll
        for (int tt = 0; tt < 2; ++tt)
#pragma unroll
            for (int i = 0; i < 2; ++i) { const int k = (tid >> 4) + 32 * i, n4 = (tid & 15) * 4;
#pragma unroll
                for (int j = 0; j < 4; ++j) tile[tt * 64 * 72 + (n4 + j) * 72 + k] = f2bf(v[tt][i][j] * gk[tt][i]); }
        __syncthreads();
#pragma unroll
        for (int tt = 0; tt < 2; ++tt) { const int t = t0 + tt * gridDim.x;
            if (t < ntiles) { const int k0 = (t % kt) * 64, n0 = (t / kt) * 64; const int n = tid >> 3, k8 = (tid & 7) * 8;
                const u32x4 w = *(const u32x4*)(tile + tt * 64 * 72 + n * 72 + k8); *(u32x4*)(dst + (size_t)(n0 + n) * K + k0 + k8) = w; } }
    }
}
__device__ __forceinline__ void prep_phase(const Args& A, unsigned char* smem) {
    u16* tile = (u16*)smem; unsigned char* ws = A.ws;
    transpose_job(A.in[1], 1024, 5152, 5376, (u16*)(ws + WS_WIN0), A.in[18], tile);
    transpose_job(A.in[13], 2048, 1024, 1024, (u16*)(ws + WS_WOUT0), nullptr, tile);
    transpose_job(A.in[20], 1024, 4096, 4096, (u16*)(ws + WS_WUP0), A.in[19], tile);
    transpose_job(A.in[20] + (size_t)1024 * 4096, 1024, 4096, 4096, (u16*)(ws + WS_WUP1), A.in[19] + 1024, tile);
    transpose_job(A.in[21], 4096, 1024, 1024, (u16*)(ws + WS_WDN0), nullptr, tile);
    transpose_job(A.in[21] + (size_t)4096 * 1024, 4096, 1024, 1024, (u16*)(ws + WS_WDN1), nullptr, tile);
    transpose_job(A.in[14], 1024, 5120, 5120, (u16*)(ws + WS_WIN1), A.in[18] + 1024, tile);
    transpose_job(A.in[17], 1024, 1024, 1024, (u16*)(ws + WS_WOUT1), nullptr, tile);
    const int tid = threadIdx.x, lane = tid & 63, wave = tid >> 6;
    float* ss = (float*)(ws + WS_SS); u16* xb = (u16*)(ws + WS_XB); const float* x = A.in[0];
    const int stride = gridDim.x * 8;
    for (int row0 = blockIdx.x * 8 + wave; row0 < NTOK; row0 += 2 * stride) {
        f32x4 v[2][4]; float s2[2] = {0.f, 0.f};
#pragma unroll
        for (int rr = 0; rr < 2; ++rr) { const int row = (row0 + rr * stride < NTOK) ? row0 + rr * stride : row0;
#pragma unroll
            for (int i = 0; i < 4; ++i) v[rr][i] = *(const f32x4*)(x + (size_t)row * DM + lane * 4 + 256 * i); }
#pragma unroll
        for (int rr = 0; rr < 2; ++rr) { const int row = (row0 + rr * stride < NTOK) ? row0 + rr * stride : row0;
#pragma unroll
            for (int i = 0; i < 4; ++i) { const size_t o = (size_t)row * DM + lane * 4 + 256 * i; const f32x4 q = v[rr][i];
                s2[rr] += q[0] * q[0] + q[1] * q[1] + q[2] * q[2] + q[3] * q[3]; u32x2 w; w.x = pk2(q[0], q[1]); w.y = pk2(q[2], q[3]); *(u32x2*)(xb + o) = w; } }
#pragma unroll
        for (int d = 1; d < 64; d <<= 1) { s2[0] += __shfl_xor(s2[0], d); s2[1] += __shfl_xor(s2[1], d); }
        if (lane == 0) { ss[row0] = s2[0]; if (row0 + stride < NTOK) ss[row0 + stride] = s2[1]; }
    }
}

typedef short v4i16_t __attribute__((ext_vector_type(4)));
__device__ __forceinline__ v4i16_t lds_tr(const u16* p) { return __builtin_amdgcn_ds_read_tr16_b64_v4i16((LAS v4i16_t*)p); }
__device__ __forceinline__ bf16x8 tr_frag(const u16* base, int pitch, int k0, int x0, int lane) {
#if TR_GATHER
    const u16* a = base + (k0 + 8 * (lane >> 4)) * pitch + x0 + (lane & 15);
    bf16x8 r;
#pragma unroll
    for (int e = 0; e < 8; ++e) r[e] = (short)a[e * pitch];
    return r;
#else
    const int g = lane >> 4, q = (lane & 15) >> 2, p = lane & 3;
    const u16* a = base + (k0 + 8 * g + q) * pitch + x0 + 4 * p;
    const v4i16_t lo = lds_tr(a), hi = lds_tr(a + 4 * pitch);
    return (bf16x8){lo[0], lo[1], lo[2], lo[3], hi[0], hi[1], hi[2], hi[3]};
#endif
}
__device__ __forceinline__ void ssd_phase(const Args& A, unsigned char* smem, const bool dry) {
    u16* Cb = (u16*)smem;
    u16* Bb = Cb + 64 * 136;
    u16* Sb = Bb + 64 * 136;
    u16* Xb0 = Sb + 64 * 136;
    u16* XWb = Xb0 + 2 * 64 * 72;
    u16* Mb = XWb + 64 * 72;
    float* yb = (float*)(Mb + 64 * 72);
    float* cw = yb + 64 * 68;
    float* cumv = cw; float* dtv = cumv + 64; float* wv = dtv + 64; float* ecv = wv + 64; float* etot = ecv + 64;
    const int tid = threadIdx.x, lane = tid & 63, wave = tid >> 6;
    u16* proj = (u16*)(A.ws + WS_PROJ); u16* tmp1 = (u16*)A.out; const float* dtraw = (const float*)(A.ws + WS_DT);
    const float* conv_w = A.in[2]; const float* conv_b = A.in[3];
    const int it = wave & 3, hh = wave >> 2, r16 = lane & 15, q4 = lane >> 4;
    for (int u = blockIdx.x; u < 256; u += gridDim.x) {
        const int b = u >> 4, h = u & 15, g = h >> 2;
        __syncthreads();
        const float Dh = A.in[6][h];
        for (int dir = 0; dir < 2; ++dir) {
            const float a_neg = -__expf(A.in[4][dir * 16 + h]); const float dtb = A.in[5][dir * 16 + h];
            f32x4 Sacc[4];
#pragma unroll
            for (int j = 0; j < 4; ++j) Sacc[j] = (f32x4){0.f, 0.f, 0.f, 0.f};
            __syncthreads();
            for (int e = tid; e < 64 * 136 / 2; e += 512) ((unsigned*)Sb)[e] = 0u;
            u32x4 pre[5]; float dpre = 0.f;
#define SSD_ISSUE(BT) do { \
    _Pragma("unroll") for (int k = 0; k < 5; ++k) { const int it_ = tid + 512 * k; const int o_ = it_ % 40, i_ = it_ / 40; \
        const int t_ = dir ? (SEQ - 1 - ((BT) * 64 + i_)) : ((BT) * 64 + i_); \
        const int col_ = o_ < 8 ? 64 * h + 8 * o_ : (o_ < 24 ? 1024 + 128 * g + 8 * (o_ - 8) : 1536 + 128 * g + 8 * (o_ - 24)); \
        pre[k] = *(const u32x4*)(proj + (size_t)(b * SEQ + t_) * PLD + col_); } \
    if (tid < 64) { const int t_ = dir ? (SEQ - 1 - ((BT) * 64 + tid)) : ((BT) * 64 + tid); dpre = dtraw[(size_t)(b * SEQ + t_) * 32 + dir * 16 + h]; } } while (0)
            SSD_ISSUE(0);
            for (int bt = 0; bt < 64; ++bt) {
                u16* Xb = Xb0 + (bt & 1) * (64 * 72);
#pragma unroll
                for (int k = 0; k < 5; ++k) { const int it_ = tid + 512 * k; const int o = it_ % 40, i = it_ / 40;
                    if (o < 8) *(u32x4*)(Xb + i * 72 + 8 * o) = pre[k];
                    else if (o < 24) *(u32x4*)(Bb + i * 136 + 8 * (o - 8)) = pre[k];
                    else *(u32x4*)(Cb + i * 136 + 8 * (o - 24)) = pre[k]; }
                if (tid < 64) {
                    const float v = dpre + dtb; const float dt = v > 20.f ? v : log1pf(__expf(v));
                    float c = dt * a_neg;
#pragma unroll
                    for (int d = 1; d < 64; d <<= 1) { const float tv = __shfl_up(c, d); if (lane >= d) c += tv; }
                    const float tot = __shfl(c, 63);
                    cumv[lane] = c; dtv[lane] = dt; wv[lane] = dt * __expf(tot - c); ecv[lane] = __expf(c); if (lane == 0) etot[0] = __expf(tot); }
                if (bt + 1 < 64) { SSD_ISSUE(bt + 1); }
                __syncthreads();
                { const int j = tid >> 3, p8 = (tid & 7) * 8; float f[8]; unpack8(*(const u32x4*)(Xb + j * 72 + p8), f); const float w = wv[j];
#pragma unroll
                    for (int e = 0; e < 8; ++e) f[e] *= w;
                    *(u32x4*)(XWb + j * 72 + p8) = pack8(f); }
                f32x4 yst[2];
                {
                    bf16x8 cf[4], bfr[2][4], sf[2][4];
#pragma unroll
                    for (int ks = 0; ks < 4; ++ks) cf[ks] = *(const bf16x8*)(Cb + (16 * it + r16) * 136 + 32 * ks + 8 * q4);
#pragma unroll
                    for (int jj = 0; jj < 2; ++jj)
#pragma unroll
                        for (int ks = 0; ks < 4; ++ks) bfr[jj][ks] = *(const bf16x8*)(Bb + (16 * (2 * hh + jj) + r16) * 136 + 32 * ks + 8 * q4);
#pragma unroll
                    for (int pp = 0; pp < 2; ++pp)
#pragma unroll
                        for (int ks = 0; ks < 4; ++ks) sf[pp][ks] = *(const bf16x8*)(Sb + (16 * (2 * hh + pp) + r16) * 136 + 32 * ks + 8 * q4);
                    const int i = 16 * it + r16; const float ci = cumv[i];
                    f32x4 cj[2], dj[2];
#pragma unroll
                    for (int jj = 0; jj < 2; ++jj) { cj[jj] = *(const f32x4*)(cumv + 16 * (2 * hh + jj) + 4 * q4); dj[jj] = *(const f32x4*)(dtv + 16 * (2 * hh + jj) + 4 * q4); }
                    __builtin_amdgcn_sched_barrier(0);
                    f32x4 gacc[2];
#pragma unroll
                    for (int jj = 0; jj < 2; ++jj) { gacc[jj] = (f32x4){0.f, 0.f, 0.f, 0.f};
#pragma unroll
                        for (int ks = 0; ks < 4; ++ks) gacc[jj] = __builtin_amdgcn_mfma_f32_16x16x32_bf16(bfr[jj][ks], cf[ks], gacc[jj], 0, 0, 0); }
#pragma unroll
                    for (int pp = 0; pp < 2; ++pp) { yst[pp] = (f32x4){0.f, 0.f, 0.f, 0.f};
#pragma unroll
                        for (int ks = 0; ks < 4; ++ks) yst[pp] = __builtin_amdgcn_mfma_f32_16x16x32_bf16(sf[pp][ks], cf[ks], yst[pp], 0, 0, 0); }
#pragma unroll
                    for (int jj = 0; jj < 2; ++jj) { const int jt = 2 * hh + jj; float m[4];
#pragma unroll
                        for (int r = 0; r < 4; ++r) { const int j = 16 * jt + 4 * q4 + r; m[r] = (j <= i) ? gacc[jj][r] * __expf(ci - cj[jj][r]) * dj[jj][r] : 0.f; }
                        u32x2 outw; outw.x = pk2(m[0], m[1]); outw.y = pk2(m[2], m[3]);
                        *(u32x2*)(Mb + (16 * it + r16) * 72 + 16 * jt + 4 * q4) = outw; }
                }
                __syncthreads();
                {
                    bf16x8 mf[2], xf[2][2], af[2], xwf[4][2];
#pragma unroll
                    for (int ks = 0; ks < 2; ++ks) mf[ks] = *(const bf16x8*)(Mb + (16 * it + r16) * 72 + 32 * ks + 8 * q4);
#pragma unroll
                    for (int pp = 0; pp < 2; ++pp)
#pragma unroll
                        for (int ks = 0; ks < 2; ++ks) xf[pp][ks] = tr_frag(Xb, 72, 32 * ks, 16 * (2 * hh + pp), lane);
#pragma unroll
                    for (int ks = 0; ks < 2; ++ks) af[ks] = tr_frag(Bb, 136, 32 * ks, 16 * wave, lane);
#pragma unroll
                    for (int pt = 0; pt < 4; ++pt)
#pragma unroll
                        for (int ks = 0; ks < 2; ++ks) xwf[pt][ks] = tr_frag(XWb, 72, 32 * ks, 16 * pt, lane);
                    const float ec1 = ecv[16 * it + r16]; const float et = etot[0];
                    __builtin_amdgcn_sched_barrier(0);
#pragma unroll
                    for (int pt = 0; pt < 4; ++pt) Sacc[pt] = Sacc[pt] * et;
                    f32x4 yin[2];
#pragma unroll
                    for (int pp = 0; pp < 2; ++pp) { yin[pp] = (f32x4){0.f, 0.f, 0.f, 0.f};
#pragma unroll
                        for (int ks = 0; ks < 2; ++ks) yin[pp] = __builtin_amdgcn_mfma_f32_16x16x32_bf16(xf[pp][ks], mf[ks], yin[pp], 0, 0, 0); }
#pragma unroll
                    for (int pt = 0; pt < 4; ++pt)
#pragma unroll
                        for (int ks = 0; ks < 2; ++ks) Sacc[pt] = __builtin_amdgcn_mfma_f32_16x16x32_bf16(af[ks], xwf[pt][ks], Sacc[pt], 0, 0, 0);
#pragma unroll
                    for (int pp = 0; pp < 2; ++pp) { const int pt = 2 * hh + pp;
                        *(f32x4*)(yb + (16 * it + r16) * 68 + 16 * pt + 4 * q4) = yin[pp] + yst[pp] * ec1; }
#pragma unroll
                    for (int pt = 0; pt < 4; ++pt) { u32x2 w; w.x = pk2(Sacc[pt][0], Sacc[pt][1]); w.y = pk2(Sacc[pt][2], Sacc[pt][3]);
                        *(u32x2*)(Sb + (16 * pt + r16) * 136 + 16 * wave + 4 * q4) = w; }
                }
                __syncthreads();
                { const int i = tid >> 3, p8 = (tid & 7) * 8; const int t = dir ? (SEQ - 1 - (bt * 64 + i)) : (bt * 64 + i); const size_t tok = (size_t)(b * SEQ + t);
                    float y[8];
#pragma unroll
                    for (int j = 0; j < 8; ++j) y[j] = yb[i * 68 + p8 + j];
                    if (dir == 0) {
                        { float xf[8]; unpack8(*(const u32x4*)(Xb + i * 72 + p8), xf);
#pragma unroll
                        for (int j = 0; j < 8; ++j) y[j] += Dh * xf[j]; }
                        if (!dry) *(u32x4*)(tmp1 + tok * 1024 + 64 * h + p8) = pack8(y);
                    } else {
                        float yf[8], z[8]; unpack8(*(const u32x4*)(tmp1 + tok * 1024 + 64 * h + p8), yf);
                        u16* zp = proj + tok * PLD + 3072 + 64 * h + p8; unpack8(*(const u32x4*)zp, z);
#pragma unroll
                        for (int j = 0; j < 8; ++j) y[j] = (y[j] + yf[j]) * siluf_(z[j]);
                        if (!dry) *(u32x4*)zp = pack8(y);
                    } }
            }
        }
    }
}

__device__ __forceinline__ void lru_phase(const Args& A, unsigned char* smem, const bool dry) {
    u16* wT = (u16*)smem;
    u16* ub = wT + 2 * 64 * 72;
    float* aL = (float*)(ub + 128 * 72);
    float* bL = aL + 128 * 64;
    float* segP = bL + 128 * 64; float* segH = segP + 512;
    float* hcar = segH + 512;
    const int tid = threadIdx.x, lane = tid & 63, wave = tid >> 6;
    u16* proj = (u16*)(A.ws + WS_PROJ); u16* tmp2 = (u16*)(A.ws + WS_TMP2);
    const int si = tid >> 3, c8 = (tid & 7) * 8, r16 = lane & 15, q4 = lane >> 4;
    for (int u = blockIdx.x; u < 256; u += gridDim.x) {
        const int b = u >> 4, nb = u & 15;
        for (int dir = 0; dir < 2; ++dir) {
            __syncthreads();
            for (int e = tid; e < 8192; e += 512) { const int gate = e >> 12, c = (e >> 6) & 63, d = e & 63;
                const float v = (gate ? A.in[10] : A.in[8])[(size_t)((dir * 16 + nb) * 64 + c) * 64 + d]; wT[(gate * 64 + d) * 72 + c] = f2bf(v); }
            if (tid < 64) hcar[tid] = 0.f;
            float ba[4], bx[4], sp[4];
#pragma unroll
            for (int dt = 0; dt < 4; ++dt) { const int ch = dir * 1024 + 64 * nb + 16 * dt + r16; ba[dt] = A.in[9][ch]; bx[dt] = A.in[11][ch];
                const float ml = -A.in[12][ch]; sp[dt] = ml > 20.f ? ml : log1pf(__expf(ml)); }
            u32x4 lpre[2];
#define LRU_ISSUE(BT) do { _Pragma("unroll") for (int k = 0; k < 2; ++k) { const int i_ = si + 64 * k; const int t_ = dir ? (SEQ - 1 - ((BT) * 128 + i_)) : ((BT) * 128 + i_); \
        lpre[k] = *(const u32x4*)(proj + (size_t)(b * SEQ + t_) * PLD + 2048 + 64 * nb + c8); } } while (0)
            LRU_ISSUE(0);
            for (int bt = 0; bt < 32; ++bt) {
                *(u32x4*)(ub + si * 72 + c8) = lpre[0]; *(u32x4*)(ub + (si + 64) * 72 + c8) = lpre[1];
                if (bt + 1 < 32) { LRU_ISSUE(bt + 1); }
                u16 hfr[16], ggr[16];
#pragma unroll
                for (int ii = 0; ii < 16; ++ii) { hfr[ii] = 0; ggr[ii] = 0; }
                if (dir) {
#pragma unroll
                    for (int ii = 0; ii < 16; ++ii) { const int i = 16 * wave + ii; const size_t tok = (size_t)(b * SEQ + (SEQ - 1 - (bt * 128 + i)));
                        hfr[ii] = tmp2[tok * 1024 + 64 * nb + lane]; ggr[ii] = proj[tok * PLD + 4096 + 64 * nb + lane]; } }
                __syncthreads();
                { bf16x8 Af[2];
#pragma unroll
                    for (int ks = 0; ks < 2; ++ks) Af[ks] = *(const bf16x8*)(ub + (16 * wave + r16) * 72 + ks * 32 + q4 * 8);
#pragma unroll
                    for (int dt = 0; dt < 4; ++dt) { const int d = 16 * dt + r16;
                        f32x4 ga = (f32x4){0.f, 0.f, 0.f, 0.f}, gx = (f32x4){0.f, 0.f, 0.f, 0.f};
#pragma unroll
                        for (int ks = 0; ks < 2; ++ks) { const bf16x8 Ba = *(const bf16x8*)(wT + (d) * 72 + ks * 32 + q4 * 8); const bf16x8 Bx = *(const bf16x8*)(wT + (64 + d) * 72 + ks * 32 + q4 * 8);
                            ga = __builtin_amdgcn_mfma_f32_16x16x32_bf16(Af[ks], Ba, ga, 0, 0, 0); gx = __builtin_amdgcn_mfma_f32_16x16x32_bf16(Af[ks], Bx, gx, 0, 0, 0); }
#pragma unroll
                        for (int j = 0; j < 4; ++j) { const int i = 16 * wave + 4 * q4 + j;
                            const float ea = 1.0f + __expf(-(ga[j] + ba[dt])), ex = 1.0f + __expf(-(gx[j] + bx[dt])); const float rab = __builtin_amdgcn_rcpf(ea * ex);
                            const float rg = rab * ex, ig = rab * ea;
                            const float la = -8.0f * rg * sp[dt]; const float av = __expf(la); const float v2 = 2.0f * la;
                            const float em = (v2 > -0.02f) ? v2 * (1.0f + v2 * (0.5f + v2 * (1.0f / 6.0f))) : (av * av - 1.0f);
                            aL[i * 64 + d] = av; bL[i * 64 + d] = sqrtf(-em) * ig * bf2f(ub[i * 72 + d]); } } }
                __syncthreads();
                float Pr[16], Hr[16];
                { float P = 1.f, hl = 0.f;
#pragma unroll
                    for (int ii = 0; ii < 16; ++ii) { const int i = 16 * wave + ii; const float av = aL[i * 64 + lane], xv = bL[i * 64 + lane]; hl = av * hl + xv; P *= av; Pr[ii] = P; Hr[ii] = hl; }
                    segP[wave * 64 + lane] = P; segH[wave * 64 + lane] = hl; }
                __syncthreads();
                { float carry = hcar[(bt & 1) * 64 + lane];
                    for (int w2 = 0; w2 < wave; ++w2) carry = segP[w2 * 64 + lane] * carry + segH[w2 * 64 + lane];
#pragma unroll
                    for (int ii = 0; ii < 16; ++ii) { const int i = 16 * wave + ii; const float hv = Hr[ii] + Pr[ii] * carry;
                        const int t = dir ? (SEQ - 1 - (bt * 128 + i)) : (bt * 128 + i); const size_t tok = (size_t)(b * SEQ + t);
                        if (dir == 0) { if (!dry) tmp2[tok * 1024 + 64 * nb + lane] = f2bf(hv); }
                        else { const u16 r = f2bf((bf2f(hfr[ii]) + hv) * gelu_tanh(bf2f(ggr[ii]))); if (!dry) proj[tok * PLD + 4096 + 64 * nb + lane] = r; } }
                    if (wave == 7) hcar[((bt + 1) & 1) * 64 + lane] = segP[7 * 64 + lane] * carry + segH[7 * 64 + lane]; }
            }
#undef LRU_ISSUE
        }
    }
}

__device__ __forceinline__ void ssd_norm_phase(const Args& A) {
    const int tid = threadIdx.x, lane = tid & 63, wave = tid >> 6; u16* proj = (u16*)(A.ws + WS_PROJ);
    float nw[16];
#pragma unroll
    for (int j = 0; j < 16; ++j) nw[j] = A.in[7][16 * lane + j];
    const int stride = gridDim.x * 8;
    for (int row0 = blockIdx.x * 8 + wave; row0 < NTOK; row0 += 2 * stride) {
        u32x4 raw[2][2];
#pragma unroll
        for (int rr = 0; rr < 2; ++rr) { const u16* p = proj + (size_t)(row0 + rr * stride) * PLD + 3072 + 16 * lane; raw[rr][0] = *(const u32x4*)p; raw[rr][1] = *(const u32x4*)(p + 8); }
#pragma unroll
        for (int rr = 0; rr < 2; ++rr) { u16* p = proj + (size_t)(row0 + rr * stride) * PLD + 3072 + 16 * lane; float f[16]; unpack8(raw[rr][0], f); unpack8(raw[rr][1], f + 8);
            float s2 = 0.f;
#pragma unroll
            for (int j = 0; j < 16; ++j) s2 += f[j] * f[j];
            s2 += __shfl_xor(s2, 1); s2 += __shfl_xor(s2, 2); s2 += __shfl_xor(s2, 4); s2 += __shfl_xor(s2, 8);
            const float rs = rsqrtf(s2 * (1.0f / 256.0f) + EPS);
#pragma unroll
            for (int j = 0; j < 16; ++j) f[j] = f[j] * rs * nw[j];
            *(u32x4*)p = pack8(f); *(u32x4*)(p + 8) = pack8(f + 8); }
    }
}

__device__ __forceinline__ void hgrn_phase(const Args& A, unsigned char* smem, const bool dry) {
    u16* Qt = (u16*)smem;
    u16* Kt = Qt + 64 * 136;
    float* yb = (float*)smem;
    u16* Kw = Kt + 64 * 136;
    u16* Vb = Kw + 64 * 136;
    u16* Sb = Vb + 64 * 136;
    u16* Ab = Sb + 128 * 136;
    float* seg = (float*)(Ab + 64 * 72);
    float* decv = seg + 16 * 128;
    const int tid = threadIdx.x, lane = tid & 63, wave = tid >> 6;
    const int it = wave & 3, hh = wave >> 2, r16 = lane & 15, q4 = lane >> 4;
    const int cq = tid & 31, tg = tid >> 5, si = tid >> 3, c16 = (tid & 7) * 16;
    u16* proj = (u16*)(A.ws + WS_PROJ);
    for (int u = blockIdx.x; u < 256; u += gridDim.x) {
        const int b = u >> 4, dir = (u >> 3) & 1, h = u & 7;
        float lbk[4];
#pragma unroll
        for (int c = 0; c < 4; ++c) lbk[c] = sigmoidf_(A.in[15][1024 + 128 * h + 4 * cq + c] - A.in[15][128 * h + 4 * cq + c]);
        f32x4 Sacc[8];
#pragma unroll
        for (int j = 0; j < 8; ++j) Sacc[j] = (f32x4){0.f, 0.f, 0.f, 0.f};
        __syncthreads();
        for (int e = tid; e < 128 * 136 / 2; e += 512) ((unsigned*)Sb)[e] = 0u;
        u32x2 frp[4], qrp[4]; u32x4 vp0, vp1;
#define HG_ISSUE(BT) do { \
    _Pragma("unroll") for (int e = 0; e < 4; ++e) { const int i_ = 4 * tg + e; const int t_ = dir ? (SEQ - 1 - ((BT) * 64 + i_)) : ((BT) * 64 + i_); const u16* row_ = proj + (size_t)(b * SEQ + t_) * PLD + 128 * h + 4 * cq; \
        frp[e] = *(const u32x2*)(row_ + 1024 + dir * 1024); qrp[e] = *(const u32x2*)(row_); } \
    { const int t_ = dir ? (SEQ - 1 - ((BT) * 64 + si)) : ((BT) * 64 + si); const u16* row_ = proj + (size_t)(b * SEQ + t_) * PLD + 3072 + 128 * h + c16; vp0 = *(const u32x4*)row_; vp1 = *(const u32x4*)(row_ + 8); } } while (0)
        HG_ISSUE(0);
        for (int bt = 0; bt < 64; ++bt) {
            float Pl[4][4], kk[4][4];
            { float P[4] = {1.0f, 1.0f, 1.0f, 1.0f};
#pragma unroll
                for (int e = 0; e < 4; ++e) { const float fr[4] = {bf_lo(frp[e].x), bf_hi(frp[e].x), bf_lo(frp[e].y), bf_hi(frp[e].y)};
#pragma unroll
                    for (int c = 0; c < 4; ++c) { const float f = lbk[c] + (1.0f - lbk[c]) * sigmoidf_(fr[c]); P[c] *= f; Pl[e][c] = P[c]; kk[e][c] = 1.0f - f; } }
                *(f32x4*)(seg + tg * 128 + 4 * cq) = (f32x4){P[0], P[1], P[2], P[3]}; }
            { *(u32x4*)(Vb + si * 136 + c16) = vp0; *(u32x4*)(Vb + si * 136 + c16 + 8) = vp1; }
            __syncthreads();
            { f32x4 pre = (f32x4){1.f, 1.f, 1.f, 1.f}, tot = pre;
#pragma unroll
                for (int g2 = 0; g2 < 16; ++g2) { const f32x4 sv = *(const f32x4*)(seg + g2 * 128 + 4 * cq); tot = tot * sv; const f32x4 pv = pre * sv; pre = (g2 < tg) ? pv : pre; }
#pragma unroll
                for (int e = 0; e < 4; ++e) { const int i = 4 * tg + e; const float qv[4] = {bf_lo(qrp[e].x), bf_hi(qrp[e].x), bf_lo(qrp[e].y), bf_hi(qrp[e].y)};
                    float oq[4], ok[4], ow[4];
#pragma unroll
                    for (int c = 0; c < 4; ++c) { const float Pc = Pl[e][c] * pre[c]; const float rP = __builtin_amdgcn_rcpf(Pc);
                        oq[c] = qv[c] * 0.08838834764831845f * Pc; ok[c] = kk[e][c] * rP; ow[c] = kk[e][c] * tot[c] * rP; }
                    u32x2 w; w.x = pk2(oq[0], oq[1]); w.y = pk2(oq[2], oq[3]); *(u32x2*)(Qt + i * 136 + 4 * cq) = w;
                    w.x = pk2(ok[0], ok[1]); w.y = pk2(ok[2], ok[3]); *(u32x2*)(Kt + i * 136 + 4 * cq) = w;
                    w.x = pk2(ow[0], ow[1]); w.y = pk2(ow[2], ow[3]); *(u32x2*)(Kw + i * 136 + 4 * cq) = w; }
                if (tg == 0) *(f32x4*)(decv + 4 * cq) = tot; }
            if (bt + 1 < 64) { HG_ISSUE(bt + 1); }
            __syncthreads();
            f32x4 yst[4];
            {
                bf16x8 aq[4], kf[2][4];
#pragma unroll
                for (int ks = 0; ks < 4; ++ks) aq[ks] = *(const bf16x8*)(Qt + (16 * it + r16) * 136 + 32 * ks + 8 * q4);
#pragma unroll
                for (int jj = 0; jj < 2; ++jj)
#pragma unroll
                    for (int ks = 0; ks < 4; ++ks) kf[jj][ks] = *(const bf16x8*)(Kt + (16 * (2 * hh + jj) + r16) * 136 + 32 * ks + 8 * q4);
                __builtin_amdgcn_sched_barrier(0);
                f32x4 gacc[2];
#pragma unroll
                for (int jj = 0; jj < 2; ++jj) { gacc[jj] = (f32x4){0.f, 0.f, 0.f, 0.f};
#pragma unroll
                    for (int ks = 0; ks < 4; ++ks) gacc[jj] = __builtin_amdgcn_mfma_f32_16x16x32_bf16(kf[jj][ks], aq[ks], gacc[jj], 0, 0, 0); }
#pragma unroll
                for (int half = 0; half < 2; ++half) {
                    bf16x8 sf[2][4];
#pragma unroll
                    for (int v2 = 0; v2 < 2; ++v2)
#pragma unroll
                        for (int ks = 0; ks < 4; ++ks) sf[v2][ks] = *(const bf16x8*)(Sb + (16 * (4 * hh + 2 * half + v2) + r16) * 136 + 32 * ks + 8 * q4);
                    __builtin_amdgcn_sched_barrier(0);
#pragma unroll
                    for (int v2 = 0; v2 < 2; ++v2) { f32x4 acc = (f32x4){0.f, 0.f, 0.f, 0.f};
#pragma unroll
                        for (int ks = 0; ks < 4; ++ks) acc = __builtin_amdgcn_mfma_f32_16x16x32_bf16(sf[v2][ks], aq[ks], acc, 0, 0, 0);
                        yst[2 * half + v2] = acc; } }
                const int i = 16 * it + r16;
#pragma unroll
                for (int jj = 0; jj < 2; ++jj) { const int jt = 2 * hh + jj; float m[4];
#pragma unroll
                    for (int r = 0; r < 4; ++r) { const int j = 16 * jt + 4 * q4 + r; m[r] = (j <= i) ? gacc[jj][r] : 0.f; }
                    u32x2 outw; outw.x = pk2(m[0], m[1]); outw.y = pk2(m[2], m[3]);
                    *(u32x2*)(Ab + (16 * it + r16) * 72 + 16 * jt + 4 * q4) = outw; }
            }
            __syncthreads();
            {
                bf16x8 aa[2], af[2], vf[8][2];
#pragma unroll
                for (int ks = 0; ks < 2; ++ks) { aa[ks] = *(const bf16x8*)(Ab + (16 * it + r16) * 72 + 32 * ks + 8 * q4); af[ks] = tr_frag(Kw, 136, 32 * ks, 16 * wave, lane); }
#pragma unroll
                for (int vt = 0; vt < 8; ++vt)
#pragma unroll
                    for (int ks = 0; ks < 2; ++ks) vf[vt][ks] = tr_frag(Vb, 136, 32 * ks, 16 * vt, lane);
                const f32x4 dec = *(const f32x4*)(decv + 16 * wave + 4 * q4);
                __builtin_amdgcn_sched_barrier(0);
#pragma unroll
                for (int vv = 0; vv < 4; ++vv) { const int vt = 4 * hh + vv; f32x4 acc = yst[vv];
#pragma unroll
                    for (int ks = 0; ks < 2; ++ks) acc = __builtin_amdgcn_mfma_f32_16x16x32_bf16((hh ? vf[4 + vv][ks] : vf[vv][ks]), aa[ks], acc, 0, 0, 0);
                    *(f32x4*)(yb + (16 * it + r16) * 132 + 16 * vt + 4 * q4) = acc; }
#pragma unroll
                for (int vt = 0; vt < 8; ++vt) { Sacc[vt] = Sacc[vt] * dec;
#pragma unroll
                    for (int ks = 0; ks < 2; ++ks) Sacc[vt] = __builtin_amdgcn_mfma_f32_16x16x32_bf16(af[ks], vf[vt][ks], Sacc[vt], 0, 0, 0);
                    u32x2 w; w.x = pk2(Sacc[vt][0], Sacc[vt][1]); w.y = pk2(Sacc[vt][2], Sacc[vt][3]);
                    *(u32x2*)(Sb + (16 * vt + r16) * 136 + 16 * wave + 4 * q4) = w; }
            }
            __syncthreads();
            { const int t = dir ? (SEQ - 1 - (bt * 64 + si)) : (bt * 64 + si); u16* dst = proj + (size_t)(b * SEQ + t) * PLD + 1024 + dir * 1024 + 128 * h + c16;
                float f[16];
#pragma unroll
                for (int j = 0; j < 16; ++j) f[j] = yb[si * 132 + c16 + j];
                if (!dry) { *(u32x4*)dst = pack8(f); *(u32x4*)(dst + 8) = pack8(f + 8); } }
        }
    }
}
__device__ __forceinline__ void hgrn_norm_phase(const Args& A) {
    const int tid = threadIdx.x, lane = tid & 63, wave = tid >> 6; u16* proj = (u16*)(A.ws + WS_PROJ);
    float nw[16];
#pragma unroll
    for (int j = 0; j < 16; ++j) nw[j] = A.in[16][16 * lane + j];
    const int stride = gridDim.x * 8;
    for (int row0 = blockIdx.x * 8 + wave; row0 < NTOK; row0 += 2 * stride) {
        u32x4 raw[2][6];
#pragma unroll
        for (int rr = 0; rr < 2; ++rr) { const u16* p = proj + (size_t)(row0 + rr * stride) * PLD + 16 * lane;
            raw[rr][0] = *(const u32x4*)(p + 1024); raw[rr][1] = *(const u32x4*)(p + 1032); raw[rr][2] = *(const u32x4*)(p + 2048); raw[rr][3] = *(const u32x4*)(p + 2056);
            raw[rr][4] = *(const u32x4*)(p + 4096); raw[rr][5] = *(const u32x4*)(p + 4104); }
#pragma unroll
        for (int rr = 0; rr < 2; ++rr) { u16* p = proj + (size_t)(row0 + rr * stride) * PLD + 16 * lane; float f[16], g[16];
            unpack8(raw[rr][0], f); unpack8(raw[rr][1], f + 8); unpack8(raw[rr][2], g); unpack8(raw[rr][3], g + 8);
            float s2 = 0.f;
#pragma unroll
            for (int j = 0; j < 16; ++j) { f[j] += g[j]; s2 += f[j] * f[j]; }
            s2 += __shfl_xor(s2, 1); s2 += __shfl_xor(s2, 2); s2 += __shfl_xor(s2, 4);
            const float rs = rsqrtf(s2 * (1.0f / 128.0f) + EPS);
            unpack8(raw[rr][4], g); unpack8(raw[rr][5], g + 8);
#pragma unroll
            for (int j = 0; j < 16; ++j) f[j] = f[j] * rs * nw[j] * siluf_(g[j]);
            *(u32x4*)p = pack8(f); *(u32x4*)(p + 8) = pack8(f + 8); }
    }
}
__device__ __forceinline__ void final_norm_phase(const Args& A) {
    const u16* xb = (const u16*)(A.ws + WS_XB); const float* ss4 = (const float*)(A.ws + WS_SSP) + (size_t)3 * NTOK * 16; float* out = A.out; const float* nf = A.in[22];
    const int c8 = (threadIdx.x & 127) * 8;
    const f32x4 g0 = *(const f32x4*)(nf + c8), g1 = *(const f32x4*)(nf + c8 + 4);
    for (int row = blockIdx.x * 4 + (threadIdx.x >> 7); row < NTOK; row += gridDim.x * 8) {
        const u32x4 r0 = *(const u32x4*)(xb + (size_t)row * DM + c8); const int row2 = (row + (int)gridDim.x * 4 < NTOK) ? row + (int)gridDim.x * 4 : row; const u32x4 r1 = *(const u32x4*)(xb + (size_t)row2 * DM + c8);
        float s0, s1;
        { const f32x4 p0 = *(const f32x4*)(ss4 + (size_t)row * 16), p1 = *(const f32x4*)(ss4 + (size_t)row * 16 + 4), p2 = *(const f32x4*)(ss4 + (size_t)row * 16 + 8), p3 = *(const f32x4*)(ss4 + (size_t)row * 16 + 12);
            s0 = ((((p0[0] + p0[1]) + (p0[2] + p0[3])) + ((p1[0] + p1[1]) + (p1[2] + p1[3]))) + (((p2[0] + p2[1]) + (p2[2] + p2[3])) + ((p3[0] + p3[1]) + (p3[2] + p3[3])))); }
        { const f32x4 p0 = *(const f32x4*)(ss4 + (size_t)row2 * 16), p1 = *(const f32x4*)(ss4 + (size_t)row2 * 16 + 4), p2 = *(const f32x4*)(ss4 + (size_t)row2 * 16 + 8), p3 = *(const f32x4*)(ss4 + (size_t)row2 * 16 + 12);
            s1 = ((((p0[0] + p0[1]) + (p0[2] + p0[3])) + ((p1[0] + p1[1]) + (p1[2] + p1[3]))) + (((p2[0] + p2[1]) + (p2[2] + p2[3])) + ((p3[0] + p3[1]) + (p3[2] + p3[3])))); }
        float f[8]; unpack8(r0, f); float rs = rsqrtf(s0 * (1.0f / 1024.0f) + EPS);
        *(f32x4*)(out + (size_t)row * DM + c8) = (f32x4){f[0], f[1], f[2], f[3]} * rs * g0; *(f32x4*)(out + (size_t)row * DM + c8 + 4) = (f32x4){f[4], f[5], f[6], f[7]} * rs * g1;
        unpack8(r1, f); rs = rsqrtf(s1 * (1.0f / 1024.0f) + EPS);
        *(f32x4*)(out + (size_t)row2 * DM + c8) = (f32x4){f[0], f[1], f[2], f[3]} * rs * g0; *(f32x4*)(out + (size_t)row2 * DM + c8 + 4) = (f32x4){f[4], f[5], f[6], f[7]} * rs * g1;
    }
}

#define XB_TMO      128
#define XB_XCNT(j)  (256  + 64 * (j))
#define XB_XSUB(j)  (1280 + 64 * (j))
#define XB_XGEN(j)  (2304 + 64 * (j))
#define XB_TOP      3328
#define XB_TOPGEN   3392
#define XCD_BAR_WORDS 3456
#define XB_SPIN_CAP (1u << 18)
__device__ __forceinline__ unsigned xb_ld(unsigned* p)              { return __hip_atomic_load(p, __ATOMIC_RELAXED, __HIP_MEMORY_SCOPE_AGENT); }
__device__ __forceinline__ unsigned xb_add(unsigned* p, unsigned v) { return __hip_atomic_fetch_add(p, v, __ATOMIC_RELAXED, __HIP_MEMORY_SCOPE_AGENT); }
__device__ __forceinline__ unsigned xb_xcc_id() { return (unsigned)__builtin_amdgcn_s_getreg((3 << 11) | 20) & 0xFu; }
#define XB_SPIN(cond, bar) do { unsigned _sp = 0; while (cond) { __builtin_amdgcn_s_sleep(1); \
    if ((++_sp & 255u) == 0u) { if (xb_ld(&(bar)[XB_TMO])) break; if (_sp > XB_SPIN_CAP) { atomicAdd(&(bar)[XB_TMO], 1u); break; } } } } while (0)
struct XcdBarrier { unsigned* bar; unsigned x; volatile LAS unsigned* st; };
__device__ __forceinline__ XcdBarrier xcd_barrier_post(unsigned* bar, volatile LAS unsigned* st) {
    XcdBarrier b; b.bar = bar; b.x = xb_xcc_id(); b.st = st;
    if (threadIdx.x == 0) (void)xb_add(&bar[XB_XCNT(b.x)], 1u);
    return b;
}
__device__ __forceinline__ void xcd_barrier_complete(unsigned* bar, unsigned x, unsigned& nloc, unsigned& nx) {
    const unsigned G = gridDim.x * gridDim.y * gridDim.z;
    unsigned sum, cnt, mine, sp = 0u;
    for (;;) {
        sum = 0u; cnt = 0u; mine = 0u;
#pragma unroll
        for (unsigned j = 0; j < 16; ++j) { const unsigned c = xb_ld(&bar[XB_XCNT(j)]); sum += c; cnt += (c > 0u) ? 1u : 0u; mine = (j == x) ? c : mine; }
        if (sum == G) break;
        __builtin_amdgcn_s_sleep(1);
        if ((++sp & 255u) == 0u) { if (xb_ld(&bar[XB_TMO])) break; if (sp > XB_SPIN_CAP) { atomicAdd(&bar[XB_TMO], 1u); break; } }
    }
    nloc = mine > 0u ? mine : 1u; nx = cnt > 0u ? cnt : 1u;
}
__device__ __forceinline__ void xcd_barrier(const XcdBarrier& b) {
    asm volatile("s_waitcnt vmcnt(0)" ::: "memory");
    __syncthreads();
    if (threadIdx.x == 0) {
        unsigned* bar = b.bar;
        __builtin_amdgcn_s_waitcnt(0);
        unsigned nloc = b.st[0], nx = b.st[1];
        if (nloc == 0u) { xcd_barrier_complete(bar, b.x, nloc, nx); b.st[0] = nloc; b.st[1] = nx; }
        const unsigned old = xb_add(&bar[XB_XSUB(b.x)], 1u);
        const unsigned gen = old / nloc;
        if (old + 1u == (gen + 1u) * nloc) {
            __builtin_amdgcn_fence(__ATOMIC_RELEASE, "agent");
            asm volatile("s_waitcnt vmcnt(0)" ::: "memory");
            const unsigned og = xb_add(&bar[XB_TOP], 1u);
            const unsigned tg = og / nx;
            if (og + 1u == (tg + 1u) * nx) xb_add(&bar[XB_TOPGEN], 1u);
            else XB_SPIN(xb_ld(&bar[XB_TOPGEN]) == tg, bar);
            __builtin_amdgcn_fence(__ATOMIC_ACQUIRE, "agent");
            xb_add(&bar[XB_XGEN(b.x)], 1u);
            asm volatile("s_waitcnt vmcnt(0)" ::: "memory");
        } else {
            XB_SPIN(xb_ld(&bar[XB_XGEN(b.x)]) == gen, bar);
            __builtin_amdgcn_fence(__ATOMIC_ACQUIRE, "agent");
            asm volatile("s_waitcnt vmcnt(0)" ::: "memory");
        }
    }
    __syncthreads();
}

__device__ __forceinline__ void conv_halo(const u16* proj, u32x4* hbuf, int id) {
    if (id < 16 * 64 * 384) { const int oc = id % 384, sg = (id / 384) & 63, b = id / (384 * 64); const int t0 = sg * 64;
        const u16* base = proj + (size_t)(b * SEQ) * PLD + 8 * oc; u32x4 h0 = (u32x4){0u, 0u, 0u, 0u}, h1 = h0, h2 = h0;
        if (t0 > 0) h0 = *(const u32x4*)(base + (size_t)(t0 - 1) * PLD);
        if (t0 + 64 < SEQ) { h1 = *(const u32x4*)(base + (size_t)(t0 + 64) * PLD); h2 = *(const u32x4*)(base + (size_t)(t0 + 65) * PLD); }
        hbuf[(size_t)id * 3] = h0; hbuf[(size_t)id * 3 + 1] = h1; hbuf[(size_t)id * 3 + 2] = h2; }
}
template <bool ACT> __device__ __forceinline__ void conv_batch(u16* base, int eb, const u32x4 (&rw)[8], float (&win)[4][8], const float (&wk)[4][8], const float (&bs)[8]) {
#pragma unroll
    for (int j = 0; j < 8; ++j) { unpack8(rw[j], win[(j + 3) & 3]);
        float acc[8];
#pragma unroll
        for (int c = 0; c < 8; ++c) { float a = bs[c];
#pragma unroll
            for (int kk = 0; kk < 4; ++kk) a += wk[kk][c] * win[(j + kk) & 3][c];
            acc[c] = ACT ? siluf_(a) : a; }
        *(u32x4*)(base + (size_t)(eb + j) * PLD) = pack8(acc); }
}
template <bool ACT> __device__ __forceinline__ void conv_sweep_t(u16* base, const float* conv_w, const float* conv_b, int oc, const u32x4 h0, const u32x4 h1, const u32x4 h2) {
    float wk[4][8], bs[8];
#pragma unroll
    for (int kk = 0; kk < 4; ++kk) { const f32x4 a0 = *(const f32x4*)(conv_w + kk * 3072 + 8 * oc), a1 = *(const f32x4*)(conv_w + kk * 3072 + 8 * oc + 4);
        wk[kk][0] = a0[0]; wk[kk][1] = a0[1]; wk[kk][2] = a0[2]; wk[kk][3] = a0[3]; wk[kk][4] = a1[0]; wk[kk][5] = a1[1]; wk[kk][6] = a1[2]; wk[kk][7] = a1[3]; }
    { const f32x4 a0 = *(const f32x4*)(conv_b + 8 * oc), a1 = *(const f32x4*)(conv_b + 8 * oc + 4);
        bs[0] = a0[0]; bs[1] = a0[1]; bs[2] = a0[2]; bs[3] = a0[3]; bs[4] = a1[0]; bs[5] = a1[1]; bs[6] = a1[2]; bs[7] = a1[3]; }
    float win[4][8];
    unpack8(h0, win[0]); unpack8(*(const u32x4*)(base), win[1]); unpack8(*(const u32x4*)(base + PLD), win[2]);
    u32x4 ra[8], rb[8];
#pragma unroll
    for (int j = 0; j < 8; ++j) ra[j] = *(const u32x4*)(base + (size_t)(2 + j) * PLD);
#pragma unroll 1
    for (int eb = 0; eb < 48; eb += 16) {
#pragma unroll
        for (int j = 0; j < 8; ++j) rb[j] = *(const u32x4*)(base + (size_t)(eb + 10 + j) * PLD);
        conv_batch<ACT>(base, eb, ra, win, wk, bs);
#pragma unroll
        for (int j = 0; j < 8; ++j) ra[j] = *(const u32x4*)(base + (size_t)(eb + 18 + j) * PLD);
        conv_batch<ACT>(base, eb + 8, rb, win, wk, bs);
    }
#pragma unroll
    for (int j = 0; j < 6; ++j) rb[j] = *(const u32x4*)(base + (size_t)(58 + j) * PLD);
    rb[6] = h1; rb[7] = h2;
    conv_batch<ACT>(base, 48, ra, win, wk, bs);
    conv_batch<ACT>(base, 56, rb, win, wk, bs);
}
__device__ __forceinline__ void conv_sweep(u16* proj, const float* conv_w, const float* conv_b, const u32x4* hbuf, int id) {
    if (id >= 16 * 64 * 384) return;
    const u32x4 h0 = hbuf[(size_t)id * 3], h1 = hbuf[(size_t)id * 3 + 1], h2 = hbuf[(size_t)id * 3 + 2];
    const int oc = id % 384, sg = (id / 384) & 63, b = id / (384 * 64); const int t0 = sg * 64;
    u16* base = proj + (size_t)(b * SEQ + t0) * PLD + 8 * oc;
    if (oc < 256) conv_sweep_t<true>(base, conv_w, conv_b, oc, h0, h1, h2);
    else conv_sweep_t<false>(base, conv_w, conv_b, oc, h0, h1, h2);
}
__device__ __forceinline__ void conv_phase(const Args& A, const XcdBarrier& xbar) {
    u16* proj = (u16*)(A.ws + WS_PROJ); const float* conv_w = A.in[2]; const float* conv_b = A.in[3];
    const int nthr = gridDim.x * 512, gt = blockIdx.x * 512 + threadIdx.x;
    u32x4* hbuf = (u32x4*)(A.ws + WS_HALO);
    conv_halo(proj, hbuf, gt); conv_halo(proj, hbuf, gt + nthr); conv_halo(proj, hbuf, gt + 2 * nthr);
    xcd_barrier(xbar);
    conv_sweep(proj, conv_w, conv_b, hbuf, gt);
    asm volatile("" ::: "memory");
    conv_sweep(proj, conv_w, conv_b, hbuf, gt + nthr);
    asm volatile("" ::: "memory");
    conv_sweep(proj, conv_w, conv_b, hbuf, gt + 2 * nthr);
}

constexpr int NPHASE = 15;
template <bool COOP>
__global__ void __launch_bounds__(512, 2) mega(Args A) {
    extern __shared__ __attribute__((aligned(16))) unsigned char smem[];
    LAS unsigned char* lds = (LAS unsigned char*)smem;
    unsigned char* ws = A.ws; const int G = gridDim.x, c = blockIdx.x;
    float* ss = (float*)(ws + WS_SS); float* ssp = (float*)(ws + WS_SSP); u16* xb = (u16*)(ws + WS_XB); u16* proj = (u16*)(ws + WS_PROJ); float* dt = (float*)(ws + WS_DT);
#define IN(k) (A.lo <= (k) && (k) < A.hi)
    XcdBarrier xbar; xbar.bar = (unsigned*)(ws + WS_BAR); xbar.x = 0; xbar.st = (volatile LAS unsigned*)(lds + 131072);
    if (COOP) { if (threadIdx.x < 4) ((LAS unsigned*)(lds + 131072))[threadIdx.x] = 0u;
        if (blockIdx.x == 0 && threadIdx.x < 51) { const int i_ = threadIdx.x;
            const int w_ = i_ < 16 ? XB_XCNT(i_) : (i_ < 32 ? XB_XSUB(i_ - 16) : (i_ < 48 ? XB_XGEN(i_ - 32) : (i_ == 48 ? XB_TOP : (i_ == 49 ? XB_TOPGEN : XB_TMO))));
            __hip_atomic_store((unsigned*)(ws + WS_BAR) + w_, 0u, __ATOMIC_RELAXED, __HIP_MEMORY_SCOPE_AGENT); }
        __syncthreads(); }
#define SEAM(k) do { if (COOP && IN(k) && IN((k) + 1)) { if ((k) == 0) { cg::this_grid().sync(); xbar = xcd_barrier_post((unsigned*)(ws + WS_BAR), (volatile LAS unsigned*)(lds + 131072)); } else xcd_barrier(xbar); } } while (0)
    if (IN(0)) prep_phase(A, smem);
    SEAM(0);
    if (IN(1)) { pg8::Gemm g{xb, (const u16*)(ws + WS_WIN0), NTOK, 5376, 1024, 1024}; pg8::StaticOrder S; S.init(NTOK, 5376, G, c);
        pg8::EpiScale<0, true, 1> E{proj, PLD, ss, dt}; pg8::gemm_phase(lds, g, S, E); }
    SEAM(1);
    if (IN(2)) conv_phase(A, xbar);
    SEAM(2);
    if (IN(3)) { ssd_phase(A, smem, false); lru_phase(A, smem, false); }
    SEAM(3);
    if (IN(4)) ssd_norm_phase(A);
    SEAM(4);
    if (IN(5)) { pg8::Gemm g{proj + 3072, (const u16*)(ws + WS_WOUT0), NTOK, 1024, 2048, PLD}; pg8::StaticOrder S; S.init(NTOK, 1024, G, c);
        pg8::EpiResid<false> E{xb, A.out, ssp}; pg8::gemm_phase(lds, g, S, E); }
    SEAM(5);
    if (IN(6)) { pg8::Gemm g{xb, (const u16*)(ws + WS_WUP0), NTOK, 4096, 1024, 1024}; pg8::StaticOrder S; S.init(NTOK, 4096, G, c);
        pg8::EpiScale<1, false, 16> E{proj, 4096, ssp, nullptr}; pg8::gemm_phase(lds, g, S, E); }
    SEAM(6);
    if (IN(7)) { pg8::Gemm g{proj, (const u16*)(ws + WS_WDN0), NTOK, 1024, 4096, 4096}; pg8::StaticOrder S; S.init(NTOK, 1024, G, c);
        pg8::EpiResid<false> E{xb, A.out, ssp + (size_t)NTOK * 16}; pg8::gemm_phase(lds, g, S, E); }
    SEAM(7);
    if (IN(8)) { pg8::Gemm g{xb, (const u16*)(ws + WS_WIN1), NTOK, 5120, 1024, 1024}; pg8::StaticOrder S; S.init(NTOK, 5120, G, c);
        pg8::EpiScale<0, false, 16> E{proj, PLD, ssp + (size_t)NTOK * 16, nullptr}; pg8::gemm_phase(lds, g, S, E); }
    SEAM(8);
    if (IN(9)) { hgrn_phase(A, smem, false); }
    SEAM(9);
    if (IN(10)) hgrn_norm_phase(A);
    SEAM(10);
    if (IN(11)) { pg8::Gemm g{proj, (const u16*)(ws + WS_WOUT1), NTOK, 1024, 1024, PLD}; pg8::StaticOrder S; S.init(NTOK, 1024, G, c);
        pg8::EpiResid<false> E{xb, A.out, ssp + (size_t)2 * NTOK * 16}; pg8::gemm_phase(lds, g, S, E); }
    SEAM(11);
    if (IN(12)) { pg8::Gemm g{xb, (const u16*)(ws + WS_WUP1), NTOK, 4096, 1024, 1024}; pg8::StaticOrder S; S.init(NTOK, 4096, G, c);
        pg8::EpiScale<1, false, 16> E{proj, 4096, ssp + (size_t)2 * NTOK * 16, nullptr}; pg8::gemm_phase(lds, g, S, E); }
    SEAM(12);
    if (IN(13)) { pg8::Gemm g{proj, (const u16*)(ws + WS_WDN1), NTOK, 1024, 4096, 4096}; pg8::StaticOrder S; S.init(NTOK, 1024, G, c);
        pg8::EpiResid<false> E{xb, A.out, ssp + (size_t)3 * NTOK * 16}; pg8::gemm_phase(lds, g, S, E); }
    SEAM(13);
    if (IN(14)) final_norm_phase(A);
#undef IN
#undef SEAM
}

#ifndef PROBE_MASK
#define PROBE_MASK 0
#endif
#ifndef N_LAUNCH_MODE
#define N_LAUNCH_MODE 1
#endif

extern "C" void kernel_launch(void* const* d_in, const int* in_sizes, int n_in, void* d_out, int out_size, void* d_ws, size_t ws_size, hipStream_t stream) {
    static int grid = 0;
    if (grid == 0) {
        if (n_in != 23 || out_size != NTOK * DM || ws_size < WS_END) { fprintf(stderr, "kernel_launch: unexpected shapes (n_in %d out %d ws %zu need %zu)\n", n_in, out_size, ws_size, (size_t)WS_END); grid = -1; return; }
        int dev = 0, cus = 0, per_cu = 0;
        (void)hipGetDevice(&dev); (void)hipDeviceGetAttribute(&cus, hipDeviceAttributeMultiprocessorCount, dev);
        (void)hipFuncSetAttribute((const void*)mega<true>, hipFuncAttributeMaxDynamicSharedMemorySize, LDS_BYTES);
#if N_LAUNCH_MODE != 1
        (void)hipFuncSetAttribute((const void*)mega<false>, hipFuncAttributeMaxDynamicSharedMemorySize, LDS_BYTES);
#endif
        (void)hipOccupancyMaxActiveBlocksPerMultiprocessor(&per_cu, (const void*)mega<true>, 512, LDS_BYTES);
        if (per_cu < 1) per_cu = 1;
        (void)hipGetLastError();
        grid = cus * per_cu;
        if (grid <= 0) grid = 256;
    }
    if (grid < 0) return;
    Args a{};
    for (int i = 0; i < 23; ++i) a.in[i] = (const float*)d_in[i];
    a.out = (float*)d_out; a.ws = (unsigned char*)d_ws; a.probe = PROBE_MASK;
#if N_LAUNCH_MODE == 1
    a.lo = 0; a.hi = NPHASE;
    void* args[] = {&a};
    hipError_t e = hipLaunchCooperativeKernel((const void*)mega<true>, dim3(grid), dim3(512), args, LDS_BYTES, stream);
    if (e != hipSuccess) fprintf(stderr, "cooperative launch failed: %s (grid %d)\n", hipGetErrorString(e), grid);
#else
    for (int k = 0; k < NPHASE; ++k) { a.lo = k; a.hi = k + 1; mega<false><<<grid, 512, LDS_BYTES, stream>>>(a); }
#endif
}
```

```cpp
#include <hip/hip_runtime.h>
#include <hip/hip_cooperative_groups.h>
#include <cstdio>
namespace cg = cooperative_groups;

#ifndef GEMM_STAGGER
#define GEMM_STAGGER 0
#endif
#ifndef TR_GATHER
#define TR_GATHER 0
#endif
#define LAS __attribute__((address_space(3)))
typedef unsigned short u16;
typedef short bf16x8 __attribute__((ext_vector_type(8)));
typedef float f32x4 __attribute__((ext_vector_type(4)));
typedef float f32x2 __attribute__((ext_vector_type(2)));
typedef unsigned u32x4 __attribute__((ext_vector_type(4)));
typedef unsigned u32x2 __attribute__((ext_vector_type(2)));

constexpr int NTOK = 65536, DM = 1024, SEQ = 4096;
constexpr int PLD = 5120;
constexpr int LDS_BYTES = 131072 + 16;
constexpr float EPS = 1e-6f;

constexpr size_t WS_WIN0 = 0;
constexpr size_t WS_WOUT0 = WS_WIN0 + (size_t)5376 * 1024 * 2;
constexpr size_t WS_WUP0 = WS_WOUT0 + (size_t)1024 * 2048 * 2;
constexpr size_t WS_WUP1 = WS_WUP0 + (size_t)4096 * 1024 * 2;
constexpr size_t WS_WDN0 = WS_WUP1 + (size_t)4096 * 1024 * 2;
constexpr size_t WS_WDN1 = WS_WDN0 + (size_t)4096 * 1024 * 2;
constexpr size_t WS_WIN1 = WS_WDN1 + (size_t)4096 * 1024 * 2;
constexpr size_t WS_WOUT1 = WS_WIN1 + (size_t)5120 * 1024 * 2;
constexpr size_t WS_SS = WS_WOUT1 + (size_t)1024 * 1024 * 2;
constexpr size_t WS_DT = WS_SS + (size_t)5 * NTOK * 4;
constexpr size_t WS_XB = WS_DT + (size_t)NTOK * 32 * 4;
constexpr size_t WS_TMP2 = WS_XB + (size_t)NTOK * 1024 * 2;
constexpr size_t WS_PROJ = WS_TMP2 + (size_t)NTOK * 1024 * 2;
constexpr size_t WS_BAR = WS_PROJ + (size_t)NTOK * PLD * 2;
constexpr size_t WS_SSP = WS_BAR + 16384;
constexpr size_t WS_HALO = WS_SSP + (size_t)4 * NTOK * 16 * 4;
constexpr size_t WS_END = WS_HALO + (size_t)16 * 64 * 384 * 48;

struct Args { const float* in[23]; float* out; unsigned char* ws; int lo, hi, probe, pad; };

__device__ __forceinline__ float bf_lo(unsigned w) { return __uint_as_float(w << 16); }
__device__ __forceinline__ float bf_hi(unsigned w) { return __uint_as_float(w & 0xffff0000u); }
__device__ __forceinline__ float bf2f(u16 b) { return __uint_as_float(((unsigned)b) << 16); }
__device__ __forceinline__ u16 f2bf(float f) { unsigned u = __float_as_uint(f); u += 0x7FFFu + ((u >> 16) & 1u); return (u16)(u >> 16); }
typedef __bf16 bf16x2_t __attribute__((ext_vector_type(2)));
__device__ __forceinline__ unsigned pk2(float lo, float hi) { const f32x2 v = (f32x2){lo, hi}; const bf16x2_t b = __builtin_convertvector(v, bf16x2_t); return __builtin_bit_cast(unsigned, b); }
__device__ __forceinline__ void unpack8(const u32x4 v, float* f) { f[0] = bf_lo(v.x); f[1] = bf_hi(v.x); f[2] = bf_lo(v.y); f[3] = bf_hi(v.y); f[4] = bf_lo(v.z); f[5] = bf_hi(v.z); f[6] = bf_lo(v.w); f[7] = bf_hi(v.w); }
__device__ __forceinline__ u32x4 pack8(const float* f) { u32x4 w; w.x = pk2(f[0], f[1]); w.y = pk2(f[2], f[3]); w.z = pk2(f[4], f[5]); w.w = pk2(f[6], f[7]); return w; }
__device__ __forceinline__ float sigmoidf_(float x) { return __builtin_amdgcn_rcpf(1.0f + __expf(-x)); }
__device__ __forceinline__ float siluf_(float x) { return x * __builtin_amdgcn_rcpf(1.0f + __expf(-x)); }
__device__ __forceinline__ float gelu_tanh(float x) { const float v = 0.7978845608028654f * (x + 0.044715f * x * x * x); const float th = 1.0f - 2.0f * __builtin_amdgcn_rcpf(__expf(2.0f * v) + 1.0f); return 0.5f * x * (1.0f + th); }

namespace pg8 {
constexpr int BM = 256, BK = 64, HALF = 128, HTB = HALF * BK * 2, STAGE_BYTES = 8 * HTB, NXCD = 8, WGM = 8;
__host__ __device__ __forceinline__ int lds_byte(int r, int c) { const int st = (r >> 4) * 2 + (c >> 5), rr = r & 15, cc = c & 31, ob = rr * 64 + cc * 2; return st * 1024 + (ob ^ (((ob >> 9) & 1) << 5)); }
__host__ __device__ __forceinline__ void stage_rc(int b, int& R, int& C) { const int st = b / 1024, sb = b % 1024, swz = sb ^ (((sb >> 9) & 1) << 5); R = (st >> 1) * 16 + swz / 64; C = (st & 1) * 32 + (swz % 64) / 2; }
__host__ __device__ __forceinline__ int perm32(int rho) { const int n = rho >> 4, i = rho & 15; return 8 * (i >> 2) + 4 * n + (i & 3); }
struct Unit { int pm, pn; };
struct Gemm { const u16* A; const u16* Bt; int M, N, K, lda; };
struct StaticOrder {
    int nM, nN, nwg, G, c;
    __device__ void init(int M, int N, int G_, int c_) { nM = M / BM; nN = N / BM; nwg = nM * nN; G = G_; c = c_; }
    __device__ bool next(int i, Unit& u) const {
        const long L = (long)i * G + c; if (L >= nwg) return false;
        int wgid = (int)L; { const int q = nwg / NXCD, r = nwg % NXCD, xcd = wgid % NXCD, off = wgid / NXCD; wgid = (xcd < r ? xcd * (q + 1) : r * (q + 1) + (xcd - r) * q) + off; }
        const int nig = WGM * nN, gid = wgid / nig, fm = gid * WGM, gsz = (nM - fm) < WGM ? (nM - fm) : WGM;
        u.pm = fm + ((wgid % nig) % gsz); u.pn = (wgid % nig) / gsz; return true;
    }
};

template <int ACT, bool DT, int SLOTS> struct EpiScale {
    static constexpr bool PERM = true;
    u16* O; int ldc; const float* ss; float* dt;
    __device__ __forceinline__ void pre(const Unit&, int, int, float (&)[8]) const {}
    __device__ __forceinline__ void operator()(const f32x4 (&acc)[2][2][4][2], const Unit& u, int wr, int wc, int fr, int fq, const float (&)[8]) const {
        const int row0 = u.pm * BM + wr * 64 + fr;
        float ep[8];
#pragma unroll
        for (int ai = 0; ai < 2; ++ai)
#pragma unroll
            for (int m = 0; m < 4; ++m) { const int row = row0 + ai * HALF + m * 16;
                if (SLOTS == 1) ep[ai * 4 + m] = ss[row];
                else { const f32x4 pq = *(const f32x4*)(ss + (size_t)row * 16 + 4 * fq); ep[ai * 4 + m] = (pq[0] + pq[1]) + (pq[2] + pq[3]); } }
        if (SLOTS != 1) {
#pragma unroll
            for (int q = 0; q < 8; ++q) { ep[q] += __shfl_xor(ep[q], 16); ep[q] += __shfl_xor(ep[q], 32); } }
        if (DT && u.pn == 20) {
            if (wc == 0) {
#pragma unroll
                for (int ai = 0; ai < 2; ++ai)
#pragma unroll
                    for (int m = 0; m < 4; ++m) { const int row = row0 + ai * HALF + m * 16; const float rs = rsqrtf(ep[ai * 4 + m] * (1.0f / 1024.0f) + EPS);
                        *(f32x4*)(dt + (size_t)row * 32 + 8 * fq) = acc[ai][0][m][0] * rs; *(f32x4*)(dt + (size_t)row * 32 + 8 * fq + 4) = acc[ai][0][m][1] * rs; }
            }
            return;
        }
        const int col0 = u.pn * BM + wc * 32 + 8 * fq;
#pragma unroll
        for (int ai = 0; ai < 2; ++ai)
#pragma unroll
            for (int m = 0; m < 4; ++m) { const int row = row0 + ai * HALF + m * 16; const float rs = rsqrtf(ep[ai * 4 + m] * (1.0f / 1024.0f) + EPS);
                u16* rowp = O + (size_t)row * ldc + col0;
#pragma unroll
                for (int bj = 0; bj < 2; ++bj) { f32x4 v0 = acc[ai][bj][m][0] * rs, v1 = acc[ai][bj][m][1] * rs;
                    if (ACT == 1) {
#pragma unroll
                        for (int j = 0; j < 4; ++j) { const float a0 = fmaxf(v0[j], 0.f), a1 = fmaxf(v1[j], 0.f); v0[j] = a0 * a0; v1[j] = a1 * a1; } }
                    u32x4 w; w.x = pk2(v0[0], v0[1]); w.y = pk2(v0[2], v0[3]); w.z = pk2(v1[0], v1[1]); w.w = pk2(v1[2], v1[3]);
                    *(u32x4*)(rowp + bj * HALF) = w; } }
    }
};
template <bool LAST> struct EpiResid {
    static constexpr bool PERM = true;
    u16* xb; float* out; float* ss;
    __device__ __forceinline__ void pre(const Unit&, int, int, float (&)[8]) const {}
    __device__ __forceinline__ void operator()(const f32x4 (&acc)[2][2][4][2], const Unit& u, int wr, int wc, int fr, int fq, const float (&)[8]) const {
        const int row0 = u.pm * BM + wr * 64 + fr, col0 = u.pn * BM + wc * 32 + 8 * fq;
#pragma unroll
        for (int ai = 0; ai < 2; ++ai) {
            u32x4 bv[4][2];
#pragma unroll
            for (int m = 0; m < 4; ++m)
#pragma unroll
                for (int bj = 0; bj < 2; ++bj) bv[m][bj] = *(const u32x4*)(xb + (size_t)(row0 + ai * HALF + m * 16) * DM + col0 + bj * HALF);
#pragma unroll
            for (int m = 0; m < 4; ++m) { const int row = row0 + ai * HALF + m * 16; const size_t ro = (size_t)row * DM + col0; float s = 0.f;
#pragma unroll
                for (int bj = 0; bj < 2; ++bj) { float b8[8]; unpack8(bv[m][bj], b8);
                    const f32x4 v0 = (f32x4){b8[0], b8[1], b8[2], b8[3]} + acc[ai][bj][m][0], v1 = (f32x4){b8[4], b8[5], b8[6], b8[7]} + acc[ai][bj][m][1];
                    s += v0[0] * v0[0] + v0[1] * v0[1] + v0[2] * v0[2] + v0[3] * v0[3] + v1[0] * v1[0] + v1[1] * v1[1] + v1[2] * v1[2] + v1[3] * v1[3];
                    if (LAST) { *(f32x4*)(out + ro + bj * HALF) = v0; *(f32x4*)(out + ro + bj * HALF + 4) = v1; }
                    else { u32x4 w; w.x = pk2(v0[0], v0[1]); w.y = pk2(v0[2], v0[3]); w.z = pk2(v1[0], v1[1]); w.w = pk2(v1[2], v1[3]); *(u32x4*)(xb + ro + bj * HALF) = w; } }
                s += __shfl_xor(s, 16); s += __shfl_xor(s, 32);
                if (fq == 0) ss[(size_t)row * 16 + u.pn * 4 + wc] = s; }
        }
    }
};

template <class Epi>
__device__ __forceinline__ void gemm_phase(LAS unsigned char* lds, const Gemm g, const StaticOrder& S, const Epi& E) {
    const int tid = threadIdx.x, wid = __builtin_amdgcn_readfirstlane(tid >> 6), lane = tid & 63, wr = wid >> 2, wc = wid & 3, fr = lane & 15, fq = lane >> 4;
    const int K = g.K, nt = K / BK, lda = g.lda;
    unsigned voffA[2], voffB[2];
#pragma unroll
    for (int i = 0; i < 2; ++i) { int R, C; stage_rc(tid * 16 + i * 8192, R, C); const int Rb = Epi::PERM ? ((R & ~31) + perm32(R & 31)) : R;
        voffA[i] = (unsigned)(R * lda + C) * 2u; voffB[i] = (unsigned)(Rb * K + C) * 2u; }
    const size_t kstep = (size_t)(BK * 2);
    const size_t hstepA = (size_t)HALF * lda * 2, hstepB = (size_t)HALF * K * 2;
    const size_t tstepA = 2 * hstepA, tstepB = 2 * hstepB;
    const unsigned ldsw = (unsigned)wid * 1024u;
    const int aoff = lds_byte(wr * 64 + fr, fq * 8), boff = lds_byte(wc * 32 + fr, fq * 8);
#define PG8_SA(b, h) (((b) * 2 + (h)) * HTB)
#define PG8_SB(b, h) ((4 + (b) * 2 + (h)) * HTB)
#define PG8_STAGE(bufoff, gbase, voff) do { _Pragma("unroll") for (int _i = 0; _i < 2; ++_i) \
        __builtin_amdgcn_global_load_lds((const unsigned*)((const char*)(gbase) + (voff)[_i]), (LAS unsigned*)(lds + (bufoff) + ldsw + _i * 8192), 16, 0, 0); } while (0)
#define PG8_LDA(dst, b, h) do { _Pragma("unroll") for (int m = 0; m < 4; ++m) _Pragma("unroll") for (int k = 0; k < 2; ++k) dst[m][k] = *(const LAS bf16x8*)(lds + PG8_SA(b, h) + aoff + m * 2048 + k * 1024); } while (0)
#define PG8_LDB(dst, b, h) do { _Pragma("unroll") for (int n = 0; n < 2; ++n) _Pragma("unroll") for (int k = 0; k < 2; ++k) dst[n][k] = *(const LAS bf16x8*)(lds + PG8_SB(b, h) + boff + n * 2048 + k * 1024); } while (0)
#define PG8_MMA(ai, bj, At, Bt) do { __builtin_amdgcn_s_setprio(1); _Pragma("unroll") for (int m = 0; m < 4; ++m) _Pragma("unroll") for (int n = 0; n < 2; ++n) _Pragma("unroll") for (int k = 0; k < 2; ++k) \
        acc[ai][bj][m][n] = __builtin_amdgcn_mfma_f32_16x16x32_bf16(Bt[n][k], At[m][k], acc[ai][bj][m][n], 0, 0, 0); __builtin_amdgcn_s_setprio(0); } while (0)
#define PG8_WAIT_V(n) asm volatile("s_waitcnt vmcnt(" #n ")" ::: "memory")
#define PG8_WAIT_L(n) asm volatile("s_waitcnt lgkmcnt(" #n ")" ::: "memory")
#define PG8_BAR __builtin_amdgcn_s_barrier()
#define PG8_SCHED __builtin_amdgcn_sched_barrier(0)
    Unit cur, nxt; int ui = 0;
    if (!S.next(0, cur)) return;
#if GEMM_STAGGER
    for (int q_ = 0; q_ < ((S.c >> 3) & 3); ++q_) __builtin_amdgcn_s_sleep(100);
#endif
    f32x4 acc[2][2][4][2];
#pragma unroll
    for (int a = 0; a < 2; ++a)
#pragma unroll
        for (int b = 0; b < 2; ++b)
#pragma unroll
            for (int m = 0; m < 4; ++m)
#pragma unroll
                for (int n = 0; n < 2; ++n) acc[a][b][m][n] = (f32x4){0.f, 0.f, 0.f, 0.f};
    bf16x8 At[4][2], B0[2][2], B1[2][2]; float epre[8];
#pragma unroll
    for (int q_ = 0; q_ < 8; ++q_) epre[q_] = 0.f;
    const char* cA = (const char*)g.A + (size_t)cur.pm * tstepA; const char* cB = (const char*)g.Bt + (size_t)cur.pn * tstepB;
    PG8_STAGE(PG8_SB(0, 0), cB, voffB); PG8_STAGE(PG8_SA(0, 0), cA, voffA); PG8_STAGE(PG8_SB(0, 1), cB + hstepB, voffB); PG8_STAGE(PG8_SA(0, 1), cA + hstepA, voffA);
    if (wr == 1) PG8_BAR;
    PG8_WAIT_V(4); PG8_BAR;
    PG8_STAGE(PG8_SB(1, 0), cB + kstep, voffB); PG8_STAGE(PG8_SA(1, 0), cA + kstep, voffA); PG8_STAGE(PG8_SB(1, 1), cB + hstepB + kstep, voffB);
    PG8_WAIT_V(6); PG8_BAR;
    for (;;) {
        const bool has_next = S.next(ui + 1, nxt);
        const char* nA = has_next ? (const char*)g.A + (size_t)nxt.pm * tstepA : cA; const char* nB = has_next ? (const char*)g.Bt + (size_t)nxt.pn * tstepB : cB;
        for (int t = 0; t < nt; t += 2) {
            const bool last = (t == nt - 2);
            const char* a1 = cA + (size_t)(t + 1) * kstep;
            const char* a2 = last ? nA : cA + (size_t)(t + 2) * kstep; const char* b2 = last ? nB : cB + (size_t)(t + 2) * kstep;
            const char* a3 = a2 + kstep; const char* b3 = b2 + kstep;
            if (last) E.pre(cur, wr, fr, epre);
            PG8_LDB(B0, 0, 0); PG8_SCHED; PG8_LDA(At, 0, 0); PG8_STAGE(PG8_SA(1, 1), a1 + hstepA, voffA);
            PG8_WAIT_L(8); PG8_BAR; PG8_WAIT_L(0); PG8_MMA(0, 0, At, B0); PG8_BAR; PG8_SCHED;
            PG8_LDB(B1, 0, 1); PG8_STAGE(PG8_SB(0, 0), b2, voffB);
            PG8_BAR; PG8_WAIT_L(0); PG8_MMA(0, 1, At, B1); PG8_BAR;
            PG8_LDA(At, 0, 1); PG8_STAGE(PG8_SA(0, 0), a2, voffA);
            PG8_BAR; PG8_WAIT_L(0); PG8_MMA(1, 0, At, B0); PG8_BAR; PG8_SCHED;
            PG8_STAGE(PG8_SB(0, 1), b2 + hstepB, voffB);
            PG8_WAIT_V(6); PG8_BAR; PG8_MMA(1, 1, At, B1); PG8_BAR;
            PG8_LDB(B0, 1, 0); PG8_SCHED; PG8_LDA(At, 1, 0); PG8_STAGE(PG8_SA(0, 1), a2 + hstepA, voffA);
            PG8_WAIT_L(8); PG8_BAR; PG8_WAIT_L(0); PG8_MMA(0, 0, At, B0); PG8_BAR; PG8_SCHED;
            PG8_LDB(B1, 1, 1); PG8_STAGE(PG8_SB(1, 0), b3, voffB);
            PG8_BAR; PG8_WAIT_L(0); PG8_MMA(0, 1, At, B1); PG8_BAR;
            PG8_LDA(At, 1, 1); PG8_STAGE(PG8_SA(1, 0), a3, voffA);
            PG8_BAR; PG8_WAIT_L(0); PG8_MMA(1, 0, At, B0); PG8_BAR; PG8_SCHED;
            PG8_STAGE(PG8_SB(1, 1), b3 + hstepB, voffB);
            PG8_WAIT_V(6); PG8_BAR; PG8_MMA(1, 1, At, B1); PG8_BAR;
        }
        E(acc, cur, wr, wc, fr, fq, epre);
        if (!has_next) break;
#pragma unroll
        for (int a = 0; a < 2; ++a)
#pragma unroll
            for (int b = 0; b < 2; ++b)
#pragma unroll
                for (int m = 0; m < 4; ++m)
#pragma unroll
                    for (int n = 0; n < 2; ++n) acc[a][b][m][n] = (f32x4){0.f, 0.f, 0.f, 0.f};
        cur = nxt; cA = nA; cB = nB; ++ui;
    }
    PG8_WAIT_V(0);
    if (wr == 0) PG8_BAR;
    PG8_BAR;
#undef PG8_SA
#undef PG8_SB
#undef PG8_STAGE
#undef PG8_LDA
#undef PG8_LDB
#undef PG8_MMA
#undef PG8_WAIT_V
#undef PG8_WAIT_L
#undef PG8_BAR
#undef PG8_SCHED
}
}

__device__ __forceinline__ void transpose_job(const float* W, int K, int N, int Npad, u16* dst, const float* gain, u16* tile) {
    const int tid = threadIdx.x, kt = K / 64, ntiles = (Npad / 64) * kt;
    for (int t0 = blockIdx.x; t0 < ntiles; t0 += 2 * gridDim.x) {
        __syncthreads();
        f32x4 v[2][2]; float gk[2][2];
#pragma unroll
        for (int tt = 0; tt < 2; ++tt) { const int t = t0 + tt * gridDim.x; const bool ok = t < ntiles; const int k0 = ok ? (t % kt) * 64 : 0, n0 = ok ? (t / kt) * 64 : 0;
#pragma unroll
            for (int i = 0; i < 2; ++i) { const int k = (tid >> 4) + 32 * i, n = n0 + (tid & 15) * 4;
                v[tt][i] = (f32x4){0.f, 0.f, 0.f, 0.f}; if (ok && n < N) v[tt][i] = *(const f32x4*)(W + (size_t)(k0 + k) * N + n);
                gk[tt][i] = gain ? gain[k0 + k] : 1.0f; } }
#pragma unroll
        for (int tt = 0; tt < 2; ++tt)
#pragma unroll
            for (int i = 0; i < 2; ++i) { const int k = (tid >> 4) + 32 * i, n4 = (tid & 15) * 4;
#pragma unroll
                for (int j = 0; j < 4; ++j) tile[tt * 64 * 72 + (n4 + j) * 72 + k] = f2bf(v[tt][i][j] * gk[tt][i]); }
        __syncthreads();
#pragma unroll
        for (int tt = 0; tt < 2; ++tt) { const int t = t0 + tt * gridDim.x;
            if (t < ntiles) { const int k0 = (t % kt) * 64, n0 = (t / kt) * 64; const int n = tid >> 3, k8 = (tid & 7) * 8;
                const u32x4 w = *(const u32x4*)(tile + tt * 64 * 72 + n * 72 + k8); *(u32x4*)(dst + (size_t)(n0 + n) * K + k0 + k8) = w; } }
    }
}
__device__ __forceinline__ void prep_phase(const Args& A, unsigned char* smem) {
    u16* tile = (u16*)smem; unsigned char* ws = A.ws;
    transpose_job(A.in[1], 1024, 5152, 5376, (u16*)(ws + WS_WIN0), A.in[18], tile);
    transpose_job(A.in[13], 2048, 1024, 1024, (u16*)(ws + WS_WOUT0), nullptr, tile);
    transpose_job(A.in[20], 1024, 4096, 4096, (u16*)(ws + WS_WUP0), A.in[19], tile);
    transpose_job(A.in[20] + (size_t)1024 * 4096, 1024, 4096, 4096, (u16*)(ws + WS_WUP1), A.in[19] + 1024, tile);
    transpose_job(A.in[21], 4096, 1024, 1024, (u16*)(ws + WS_WDN0), nullptr, tile);
    transpose_job(A.in[21] + (size_t)4096 * 1024, 4096, 1024, 1024, (u16*)(ws + WS_WDN1), nullptr, tile);
    transpose_job(A.in[14], 1024, 5120, 5120, (u16*)(ws + WS_WIN1), A.in[18] + 1024, tile);
    transpose_job(A.in[17], 1024, 1024, 1024, (u16*)(ws + WS_WOUT1), nullptr, tile);
    const int tid = threadIdx.x, lane = tid & 63, wave = tid >> 6;
    float* ss = (float*)(ws + WS_SS); u16* xb = (u16*)(ws + WS_XB); const float* x = A.in[0];
    const int stride = gridDim.x * 8;
    for (int row0 = blockIdx.x * 8 + wave; row0 < NTOK; row0 += 2 * stride) {
        f32x4 v[2][4]; float s2[2] = {0.f, 0.f};
#pragma unroll
        for (int rr = 0; rr < 2; ++rr) { const int row = (row0 + rr * stride < NTOK) ? row0 + rr * stride : row0;
#pragma unroll
            for (int i = 0; i < 4; ++i) v[rr][i] = *(const f32x4*)(x + (size_t)row * DM + lane * 4 + 256 * i); }
#pragma unroll
        for (int rr = 0; rr < 2; ++rr) { const int row = (row0 + rr * stride < NTOK) ? row0 + rr * stride : row0;
#pragma unroll
            for (int i = 0; i < 4; ++i) { const size_t o = (size_t)row * DM + lane * 4 + 256 * i; const f32x4 q = v[rr][i];
                s2[rr] += q[0] * q[0] + q[1] * q[1] + q[2] * q[2] + q[3] * q[3]; u32x2 w; w.x = pk2(q[0], q[1]); w.y = pk2(q[2], q[3]); *(u32x2*)(xb + o) = w; } }
#pragma unroll
        for (int d = 1; d < 64; d <<= 1) { s2[0] += __shfl_xor(s2[0], d); s2[1] += __shfl_xor(s2[1], d); }
        if (lane == 0) { ss[row0] = s2[0]; if (row0 + stride < NTOK) ss[row0 + stride] = s2[1]; }
    }
}

typedef short v4i16_t __attribute__((ext_vector_type(4)));
__device__ __forceinline__ v4i16_t lds_tr(const u16* p) { return __builtin_amdgcn_ds_read_tr16_b64_v4i16((LAS v4i16_t*)p); }
__device__ __forceinline__ bf16x8 tr_frag(const u16* base, int pitch, int k0, int x0, int lane) {
#if TR_GATHER
    const u16* a = base + (k0 + 8 * (lane >> 4)) * pitch + x0 + (lane & 15);
    bf16x8 r;
#pragma unroll
    for (int e = 0; e < 8; ++e) r[e] = (short)a[e * pitch];
    return r;
#else
    const int g = lane >> 4, q = (lane & 15) >> 2, p = lane & 3;
    const u16* a = base + (k0 + 8 * g + q) * pitch + x0 + 4 * p;
    const v4i16_t lo = lds_tr(a), hi = lds_tr(a + 4 * pitch);
    return (bf16x8){lo[0], lo[1], lo[2], lo[3], hi[0], hi[1], hi[2], hi[3]};
#endif
}
__device__ __forceinline__ void ssd_phase(const Args& A, unsigned char* smem, const bool dry) {
    u16* Cb = (u16*)smem;
    u16* Bb = Cb + 64 * 136;
    u16* Sb = Bb + 64 * 136;
    u16* Xb0 = Sb + 64 * 136;
    u16* XWb = Xb0 + 2 * 64 * 72;
    u16* Mb = XWb + 64 * 72;
    float* yb = (float*)(Mb + 64 * 72);
    float* cw = yb + 4096;
    float* cumv = cw; float* dtv = cumv + 64; float* wv = dtv + 64; float* ecv = wv + 64; float* etot = ecv + 64;
    const int tid = threadIdx.x, lane = tid & 63, wave = tid >> 6;
    u16* proj = (u16*)(A.ws + WS_PROJ); u16* tmp1 = (u16*)A.out; const float* dtraw = (const float*)(A.ws + WS_DT);
    const float* conv_w = A.in[2]; const float* conv_b = A.in[3];
    const int it = wave & 3, hh = wave >> 2, r16 = lane & 15, q4 = lane >> 4;
    for (int u = blockIdx.x; u < 256; u += gridDim.x) {
        const int b = u >> 4, h = u & 15, g = h >> 2;
        __syncthreads();
        const float Dh = A.in[6][h];
        for (int dir = 0; dir < 2; ++dir) {
            const float a_neg = -__expf(A.in[4][dir * 16 + h]); const float dtb = A.in[5][dir * 16 + h];
            f32x4 Sacc[4];
#pragma unroll
            for (int j = 0; j < 4; ++j) Sacc[j] = (f32x4){0.f, 0.f, 0.f, 0.f};
            __syncthreads();
            for (int e = tid; e < 64 * 136 / 2; e += 512) ((unsigned*)Sb)[e] = 0u;
            u32x4 pre[5]; float dpre = 0.f;
#define SSD_ISSUE(BT) do { \
    _Pragma("unroll") for (int k = 0; k < 5; ++k) { const int it_ = tid + 512 * k; const int o_ = it_ % 40, i_ = it_ / 40; \
        const int t_ = dir ? (SEQ - 1 - ((BT) * 64 + i_)) : ((BT) * 64 + i_); \
        const int col_ = o_ < 8 ? 64 * h + 8 * o_ : (o_ < 24 ? 1024 + 128 * g + 8 * (o_ - 8) : 1536 + 128 * g + 8 * (o_ - 24)); \
        pre[k] = *(const u32x4*)(proj + (size_t)(b * SEQ + t_) * PLD + col_); } \
    if (tid < 64) { const int t_ = dir ? (SEQ - 1 - ((BT) * 64 + tid)) : ((BT) * 64 + tid); dpre = dtraw[(size_t)(b * SEQ + t_) * 32 + dir * 16 + h]; } } while (0)
            SSD_ISSUE(0);
            for (int bt = 0; bt < 64; ++bt) {
                u16* Xb = Xb0 + (bt & 1) * (64 * 72);
#pragma unroll
                for (int k = 0; k < 5; ++k) { const int it_ = tid + 512 * k; const int o = it_ % 40, i = it_ / 40;
                    if (o < 8) *(u32x4*)(Xb + i * 72 + 8 * o) = pre[k];
                    else if (o < 24) *(u32x4*)(Bb + i * 136 + 8 * (o - 8)) = pre[k];
                    else *(u32x4*)(Cb + i * 136 + 8 * (o - 24)) = pre[k]; }
                if (tid < 64) {
                    const float v = dpre + dtb; const float dt = v > 20.f ? v : log1pf(__expf(v));
                    float c = dt * a_neg;
#pragma unroll
                    for (int d = 1; d < 64; d <<= 1) { const float tv = __shfl_up(c, d); if (lane >= d) c += tv; }
                    const float tot = __shfl(c, 63);
                    cumv[lane] = c; dtv[lane] = dt; wv[lane] = dt * __expf(tot - c); ecv[lane] = __expf(c); if (lane == 0) etot[0] = __expf(tot); }
                if (bt + 1 < 64) { SSD_ISSUE(bt + 1); }
                __syncthreads();
                { const int j = tid >> 3, p8 = (tid & 7) * 8; float f[8]; unpack8(*(const u32x4*)(Xb + j * 72 + p8), f); const float w = wv[j];
#pragma unroll
                    for (int e = 0; e < 8; ++e) f[e] *= w;
                    *(u32x4*)(XWb + j * 72 + p8) = pack8(f); }
                f32x4 yst[2];
                {
                    bf16x8 cf[4], bfr[2][4], sf[2][4];
#pragma unroll
                    for (int ks = 0; ks < 4; ++ks) cf[ks] = *(const bf16x8*)(Cb + (16 * it + r16) * 136 + 32 * ks + 8 * q4);
#pragma unroll
                    for (int jj = 0; jj < 2; ++jj)
#pragma unroll
                        for (int ks = 0; ks < 4; ++ks) bfr[jj][ks] = *(const bf16x8*)(Bb + (16 * (2 * hh + jj) + r16) * 136 + 32 * ks + 8 * q4);
#pragma unroll
                    for (int pp = 0; pp < 2; ++pp)
#pragma unroll
                        for (int ks = 0; ks < 4; ++ks) sf[pp][ks] = *(const bf16x8*)(Sb + (16 * (2 * hh + pp) + r16) * 136 + 32 * ks + 8 * q4);
                    const int i = 16 * it + r16; const float ci = cumv[i];
                    f32x4 cj[2], dj[2];
#pragma unroll
                    for (int jj = 0; jj < 2; ++jj) { cj[jj] = *(const f32x4*)(cumv + 16 * (2 * hh + jj) + 4 * q4); dj[jj] = *(const f32x4*)(dtv + 16 * (2 * hh + jj) + 4 * q4); }
                    __builtin_amdgcn_sched_barrier(0);
                    f32x4 gacc[2];
#pragma unroll
                    for (int jj = 0; jj < 2; ++jj) { gacc[jj] = (f32x4){0.f, 0.f, 0.f, 0.f};
#pragma unroll
                        for (int ks = 0; ks < 4; ++ks) gacc[jj] = __builtin_amdgcn_mfma_f32_16x16x32_bf16(bfr[jj][ks], cf[ks], gacc[jj], 0, 0, 0); }
#pragma unroll
                    for (int pp = 0; pp < 2; ++pp) { yst[pp] = (f32x4){0.f, 0.f, 0.f, 0.f};
#pragma unroll
                        for (int ks = 0; ks < 4; ++ks) yst[pp] = __builtin_amdgcn_mfma_f32_16x16x32_bf16(cf[ks], sf[pp][ks], yst[pp], 0, 0, 0); }
#pragma unroll
                    for (int jj = 0; jj < 2; ++jj) { const int jt = 2 * hh + jj; float m[4];
#pragma unroll
                        for (int r = 0; r < 4; ++r) { const int j = 16 * jt + 4 * q4 + r; m[r] = (j <= i) ? gacc[jj][r] * __expf(ci - cj[jj][r]) * dj[jj][r] : 0.f; }
                        u32x2 outw; outw.x = pk2(m[0], m[1]); outw.y = pk2(m[2], m[3]);
                        *(u32x2*)(Mb + (16 * it + r16) * 72 + 16 * jt + 4 * q4) = outw; }
                }
                __syncthreads();
                {
                    bf16x8 mf[2], xf[2][2], af[2], xwf[4][2];
#pragma unroll
                    for (int ks = 0; ks < 2; ++ks) mf[ks] = *(const bf16x8*)(Mb + (16 * it + r16) * 72 + 32 * ks + 8 * q4);
#pragma unroll
                    for (int pp = 0; pp < 2; ++pp)
#pragma unroll
                        for (int ks = 0; ks < 2; ++ks) xf[pp][ks] = tr_frag(Xb, 72, 32 * ks, 16 * (2 * hh + pp), lane);
#pragma unroll
                    for (int ks = 0; ks < 2; ++ks) af[ks] = tr_frag(Bb, 136, 32 * ks, 16 * wave, lane);
#pragma unroll
                    for (int pt = 0; pt < 4; ++pt)
#pragma unroll
                        for (int ks = 0; ks < 2; ++ks) xwf[pt][ks] = tr_frag(XWb, 72, 32 * ks, 16 * pt, lane);
                    const f32x4 ec = *(const f32x4*)(ecv + 16 * it + 4 * q4); const float et = etot[0];
                    __builtin_amdgcn_sched_barrier(0);
#pragma unroll
                    for (int pt = 0; pt < 4; ++pt) Sacc[pt] = Sacc[pt] * et;
                    f32x4 yin[2];
#pragma unroll
                    for (int pp = 0; pp < 2; ++pp) { yin[pp] = (f32x4){0.f, 0.f, 0.f, 0.f};
#pragma unroll
                        for (int ks = 0; ks < 2; ++ks) yin[pp] = __builtin_amdgcn_mfma_f32_16x16x32_bf16(mf[ks], xf[pp][ks], yin[pp], 0, 0, 0); }
#pragma unroll
                    for (int pt = 0; pt < 4; ++pt)
#pragma unroll
                        for (int ks = 0; ks < 2; ++ks) Sacc[pt] = __builtin_amdgcn_mfma_f32_16x16x32_bf16(af[ks], xwf[pt][ks], Sacc[pt], 0, 0, 0);
#pragma unroll
                    for (int pp = 0; pp < 2; ++pp) { const int pt = 2 * hh + pp;
#pragma unroll
                        for (int r = 0; r < 4; ++r) { const int i = 16 * it + 4 * q4 + r; yb[i * 64 + 16 * pt + r16] = yin[pp][r] + ec[r] * yst[pp][r]; } }
#pragma unroll
                    for (int pt = 0; pt < 4; ++pt) { u32x2 w; w.x = pk2(Sacc[pt][0], Sacc[pt][1]); w.y = pk2(Sacc[pt][2], Sacc[pt][3]);
                        *(u32x2*)(Sb + (16 * pt + r16) * 136 + 16 * wave + 4 * q4) = w; }
                }
                __syncthreads();
                { const int i = tid >> 3, p8 = (tid & 7) * 8; const int t = dir ? (SEQ - 1 - (bt * 64 + i)) : (bt * 64 + i); const size_t tok = (size_t)(b * SEQ + t);
                    float y[8];
#pragma unroll
                    for (int j = 0; j < 8; ++j) y[j] = yb[i * 64 + p8 + j];
                    if (dir == 0) {
                        { float xf[8]; unpack8(*(const u32x4*)(Xb + i * 72 + p8), xf);
#pragma unroll
                        for (int j = 0; j < 8; ++j) y[j] += Dh * xf[j]; }
                        if (!dry) *(u32x4*)(tmp1 + tok * 1024 + 64 * h + p8) = pack8(y);
                    } else {
                        float yf[8], z[8]; unpack8(*(const u32x4*)(tmp1 + tok * 1024 + 64 * h + p8), yf);
                        u16* zp = proj + tok * PLD + 3072 + 64 * h + p8; unpack8(*(const u32x4*)zp, z);
#pragma unroll
                        for (int j = 0; j < 8; ++j) y[j] = (y[j] + yf[j]) * siluf_(z[j]);
                        if (!dry) *(u32x4*)zp = pack8(y);
                    } }
            }
        }
    }
}

__device__ __forceinline__ void lru_phase(const Args& A, unsigned char* smem, const bool dry) {
    u16* wT = (u16*)smem;
    u16* ub = wT + 2 * 64 * 72;
    constexpr int AP = 68;
    float* aL = (float*)(ub + 128 * 72);
    float* bL = aL + 128 * AP;
    float* segP = bL + 128 * AP; float* segH = segP + 512;
    float* hcar = segH + 512;
    float* cst = hcar + 128;
    const int tid = threadIdx.x, lane = tid & 63, wave = tid >> 6;
    u16* proj = (u16*)(A.ws + WS_PROJ); u16* tmp2 = (u16*)(A.ws + WS_TMP2);
    const int si = tid >> 3, c8 = (tid & 7) * 8, r16 = lane & 15, q4 = lane >> 4;
    for (int u = blockIdx.x; u < 256; u += gridDim.x) {
        const int b = u >> 4, nb = u & 15;
        for (int dir = 0; dir < 2; ++dir) {
            __syncthreads();
            for (int e = tid; e < 8192; e += 512) { const int gate = e >> 12, c = (e >> 6) & 63, d = e & 63;
                const float v = (gate ? A.in[10] : A.in[8])[(size_t)((dir * 16 + nb) * 64 + c) * 64 + d]; wT[(gate * 64 + d) * 72 + c] = f2bf(v); }
            if (tid < 64) hcar[tid] = 0.f;
            if (tid < 64) { const int ch = dir * 1024 + 64 * nb + tid; cst[tid] = A.in[9][ch]; cst[64 + tid] = A.in[11][ch];
                const float ml = -A.in[12][ch]; cst[128 + tid] = ml > 20.f ? ml : log1pf(__expf(ml)); }
            u32x4 lpre[2];
#define LRU_ISSUE(BT) do { _Pragma("unroll") for (int k = 0; k < 2; ++k) { const int i_ = si + 64 * k; const int t_ = dir ? (SEQ - 1 - ((BT) * 128 + i_)) : ((BT) * 128 + i_); \
        lpre[k] = *(const u32x4*)(proj + (size_t)(b * SEQ + t_) * PLD + 2048 + 64 * nb + c8); } } while (0)
            LRU_ISSUE(0);
            for (int bt = 0; bt < 32; ++bt) {
                *(u32x4*)(ub + si * 72 + c8) = lpre[0]; *(u32x4*)(ub + (si + 64) * 72 + c8) = lpre[1];
                if (bt + 1 < 32) { LRU_ISSUE(bt + 1); }
                u16 hfr[16], ggr[16];
#pragma unroll
                for (int ii = 0; ii < 16; ++ii) { hfr[ii] = 0; ggr[ii] = 0; }
                if (dir) {
#pragma unroll
                    for (int ii = 0; ii < 16; ++ii) { const int i = 16 * wave + ii; const size_t tok = (size_t)(b * SEQ + (SEQ - 1 - (bt * 128 + i)));
                        hfr[ii] = tmp2[tok * 1024 + 64 * nb + lane]; ggr[ii] = proj[tok * PLD + 4096 + 64 * nb + lane]; } }
                __syncthreads();
                { bf16x8 Af[2];
#pragma unroll
                    for (int ks = 0; ks < 2; ++ks) Af[ks] = *(const bf16x8*)(ub + (16 * wave + r16) * 72 + ks * 32 + q4 * 8);
#pragma unroll
                    for (int dt = 0; dt < 4; ++dt) { const int dr = 16 * dt + r16;
                        f32x4 ga = (f32x4){0.f, 0.f, 0.f, 0.f}, gx = (f32x4){0.f, 0.f, 0.f, 0.f};
#pragma unroll
                        for (int ks = 0; ks < 2; ++ks) { const bf16x8 Ba = *(const bf16x8*)(wT + (dr) * 72 + ks * 32 + q4 * 8); const bf16x8 Bx = *(const bf16x8*)(wT + (64 + dr) * 72 + ks * 32 + q4 * 8);
                            ga = __builtin_amdgcn_mfma_f32_16x16x32_bf16(Ba, Af[ks], ga, 0, 0, 0); gx = __builtin_amdgcn_mfma_f32_16x16x32_bf16(Bx, Af[ks], gx, 0, 0, 0); }
                        const int i = 16 * wave + r16, d0 = 16 * dt + 4 * q4;
                        const f32x4 cba = *(const f32x4*)(cst + d0), cbx = *(const f32x4*)(cst + 64 + d0), csp = *(const f32x4*)(cst + 128 + d0);
                        const u32x2 uw = *(const u32x2*)(ub + i * 72 + d0); const float uu[4] = {bf_lo(uw.x), bf_hi(uw.x), bf_lo(uw.y), bf_hi(uw.y)};
                        f32x4 oa, ob;
#pragma unroll
                        for (int j = 0; j < 4; ++j) {
                            const float ea = 1.0f + __expf(-(ga[j] + cba[j])), ex = 1.0f + __expf(-(gx[j] + cbx[j])); const float rab = __builtin_amdgcn_rcpf(ea * ex);
                            const float rg = rab * ex, ig = rab * ea;
                            const float la = -8.0f * rg * csp[j]; const float av = __expf(la); const float v2 = 2.0f * la;
                            const float em = (v2 > -0.02f) ? v2 * (1.0f + v2 * (0.5f + v2 * (1.0f / 6.0f))) : (av * av - 1.0f);
                            oa[j] = av; ob[j] = sqrtf(-em) * ig * uu[j]; }
                        *(f32x4*)(aL + i * AP + d0) = oa; *(f32x4*)(bL + i * AP + d0) = ob; } }
                __syncthreads();
                float Pr[16], Hr[16];
                { float P = 1.f, hl = 0.f;
#pragma unroll
                    for (int ii = 0; ii < 16; ++ii) { const int i = 16 * wave + ii; const float av = aL[i * AP + lane], xv = bL[i * AP + lane]; hl = av * hl + xv; P *= av; Pr[ii] = P; Hr[ii] = hl; }
                    segP[wave * 64 + lane] = P; segH[wave * 64 + lane] = hl; }
                __syncthreads();
                { float carry = hcar[(bt & 1) * 64 + lane];
                    for (int w2 = 0; w2 < wave; ++w2) carry = segP[w2 * 64 + lane] * carry + segH[w2 * 64 + lane];
#pragma unroll
                    for (int ii = 0; ii < 16; ++ii) { const int i = 16 * wave + ii; const float hv = Hr[ii] + Pr[ii] * carry;
                        const int t = dir ? (SEQ - 1 - (bt * 128 + i)) : (bt * 128 + i); const size_t tok = (size_t)(b * SEQ + t);
                        if (dir == 0) { if (!dry) tmp2[tok * 1024 + 64 * nb + lane] = f2bf(hv); }
                        else { const u16 r = f2bf((bf2f(hfr[ii]) + hv) * gelu_tanh(bf2f(ggr[ii]))); if (!dry) proj[tok * PLD + 4096 + 64 * nb + lane] = r; } }
                    if (wave == 7) hcar[((bt + 1) & 1) * 64 + lane] = segP[7 * 64 + lane] * carry + segH[7 * 64 + lane]; }
            }
#undef LRU_ISSUE
        }
    }
}

__device__ __forceinline__ void ssd_norm_phase(const Args& A) {
    const int tid = threadIdx.x, lane = tid & 63, wave = tid >> 6; u16* proj = (u16*)(A.ws + WS_PROJ);
    float nw[16];
#pragma unroll
    for (int j = 0; j < 16; ++j) nw[j] = A.in[7][16 * lane + j];
    const int stride = gridDim.x * 8;
    for (int row0 = blockIdx.x * 8 + wave; row0 < NTOK; row0 += 2 * stride) {
        u32x4 raw[2][2];
#pragma unroll
        for (int rr = 0; rr < 2; ++rr) { const u16* p = proj + (size_t)(row0 + rr * stride) * PLD + 3072 + 16 * lane; raw[rr][0] = *(const u32x4*)p; raw[rr][1] = *(const u32x4*)(p + 8); }
#pragma unroll
        for (int rr = 0; rr < 2; ++rr) { u16* p = proj + (size_t)(row0 + rr * stride) * PLD + 3072 + 16 * lane; float f[16]; unpack8(raw[rr][0], f); unpack8(raw[rr][1], f + 8);
            float s2 = 0.f;
#pragma unroll
            for (int j = 0; j < 16; ++j) s2 += f[j] * f[j];
            s2 += __shfl_xor(s2, 1); s2 += __shfl_xor(s2, 2); s2 += __shfl_xor(s2, 4); s2 += __shfl_xor(s2, 8);
            const float rs = rsqrtf(s2 * (1.0f / 256.0f) + EPS);
#pragma unroll
            for (int j = 0; j < 16; ++j) f[j] = f[j] * rs * nw[j];
            *(u32x4*)p = pack8(f); *(u32x4*)(p + 8) = pack8(f + 8); }
    }
}

__device__ __forceinline__ void hgrn_phase(const Args& A, unsigned char* smem, const bool dry) {
    u16* Qt = (u16*)smem;
    u16* Kt = Qt + 64 * 136;
    float* yb = (float*)smem;
    u16* Kw = Kt + 64 * 136;
    u16* Vb = Kw + 64 * 136;
    u16* Sb = Vb + 64 * 136;
    u16* Ab = Sb + 128 * 136;
    float* seg = (float*)(Ab + 64 * 72);
    float* decv = seg + 16 * 128;
    const int tid = threadIdx.x, lane = tid & 63, wave = tid >> 6;
    const int it = wave & 3, hh = wave >> 2, r16 = lane & 15, q4 = lane >> 4;
    const int cq = tid & 31, tg = tid >> 5, si = tid >> 3, c16 = (tid & 7) * 16;
    u16* proj = (u16*)(A.ws + WS_PROJ);
    for (int u = blockIdx.x; u < 256; u += gridDim.x) {
        const int b = u >> 4, dir = (u >> 3) & 1, h = u & 7;
        float lbk[4];
#pragma unroll
        for (int c = 0; c < 4; ++c) lbk[c] = sigmoidf_(A.in[15][1024 + 128 * h + 4 * cq + c] - A.in[15][128 * h + 4 * cq + c]);
        f32x4 Sacc[8];
#pragma unroll
        for (int j = 0; j < 8; ++j) Sacc[j] = (f32x4){0.f, 0.f, 0.f, 0.f};
        __syncthreads();
        for (int e = tid; e < 128 * 136 / 2; e += 512) ((unsigned*)Sb)[e] = 0u;
        u32x2 frp[4], qrp[4]; u32x4 vp0, vp1;
#define HG_ISSUE(BT) do { \
    _Pragma("unroll") for (int e = 0; e < 4; ++e) { const int i_ = 4 * tg + e; const int t_ = dir ? (SEQ - 1 - ((BT) * 64 + i_)) : ((BT) * 64 + i_); const u16* row_ = proj + (size_t)(b * SEQ + t_) * PLD + 128 * h + 4 * cq; \
        frp[e] = *(const u32x2*)(row_ + 1024 + dir * 1024); qrp[e] = *(const u32x2*)(row_); } \
    { const int t_ = dir ? (SEQ - 1 - ((BT) * 64 + si)) : ((BT) * 64 + si); const u16* row_ = proj + (size_t)(b * SEQ + t_) * PLD + 3072 + 128 * h + c16; vp0 = *(const u32x4*)row_; vp1 = *(const u32x4*)(row_ + 8); } } while (0)
        HG_ISSUE(0);
        for (int bt = 0; bt < 64; ++bt) {
            float Pl[4][4], kk[4][4];
            { float P[4] = {1.0f, 1.0f, 1.0f, 1.0f};
#pragma unroll
                for (int e = 0; e < 4; ++e) { const float fr[4] = {bf_lo(frp[e].x), bf_hi(frp[e].x), bf_lo(frp[e].y), bf_hi(frp[e].y)};
#pragma unroll
                    for (int c = 0; c < 4; ++c) { const float f = lbk[c] + (1.0f - lbk[c]) * sigmoidf_(fr[c]); P[c] *= f; Pl[e][c] = P[c]; kk[e][c] = 1.0f - f; } }
                *(f32x4*)(seg + tg * 128 + 4 * cq) = (f32x4){P[0], P[1], P[2], P[3]}; }
            { *(u32x4*)(Vb + si * 136 + c16) = vp0; *(u32x4*)(Vb + si * 136 + c16 + 8) = vp1; }
            __syncthreads();
            { f32x4 pre = (f32x4){1.f, 1.f, 1.f, 1.f}, tot = pre;
#pragma unroll
                for (int g2 = 0; g2 < 16; ++g2) { const f32x4 sv = *(const f32x4*)(seg + g2 * 128 + 4 * cq); tot = tot * sv; const f32x4 pv = pre * sv; pre = (g2 < tg) ? pv : pre; }
#pragma unroll
                for (int e = 0; e < 4; ++e) { const int i = 4 * tg + e; const float qv[4] = {bf_lo(qrp[e].x), bf_hi(qrp[e].x), bf_lo(qrp[e].y), bf_hi(qrp[e].y)};
                    float oq[4], ok[4], ow[4];
#pragma unroll
                    for (int c = 0; c < 4; ++c) { const float Pc = Pl[e][c] * pre[c]; const float rP = __builtin_amdgcn_rcpf(Pc);
                        oq[c] = qv[c] * 0.08838834764831845f * Pc; ok[c] = kk[e][c] * rP; ow[c] = kk[e][c] * tot[c] * rP; }
                    u32x2 w; w.x = pk2(oq[0], oq[1]); w.y = pk2(oq[2], oq[3]); *(u32x2*)(Qt + i * 136 + 4 * cq) = w;
                    w.x = pk2(ok[0], ok[1]); w.y = pk2(ok[2], ok[3]); *(u32x2*)(Kt + i * 136 + 4 * cq) = w;
                    w.x = pk2(ow[0], ow[1]); w.y = pk2(ow[2], ow[3]); *(u32x2*)(Kw + i * 136 + 4 * cq) = w; }
                if (tg == 0) *(f32x4*)(decv + 4 * cq) = tot; }
            if (bt + 1 < 64) { HG_ISSUE(bt + 1); }
            __syncthreads();
            f32x4 yst[4];
            {
                bf16x8 aq[4], kf[2][4];
#pragma unroll
                for (int ks = 0; ks < 4; ++ks) aq[ks] = *(const bf16x8*)(Qt + (16 * it + r16) * 136 + 32 * ks + 8 * q4);
#pragma unroll
                for (int jj = 0; jj < 2; ++jj)
#pragma unroll
                    for (int ks = 0; ks < 4; ++ks) kf[jj][ks] = *(const bf16x8*)(Kt + (16 * (2 * hh + jj) + r16) * 136 + 32 * ks + 8 * q4);
                __builtin_amdgcn_sched_barrier(0);
                f32x4 gacc[2];
#pragma unroll
                for (int jj = 0; jj < 2; ++jj) { gacc[jj] = (f32x4){0.f, 0.f, 0.f, 0.f};
#pragma unroll
                    for (int ks = 0; ks < 4; ++ks) gacc[jj] = __builtin_amdgcn_mfma_f32_16x16x32_bf16(kf[jj][ks], aq[ks], gacc[jj], 0, 0, 0); }
#pragma unroll
                for (int half = 0; half < 2; ++half) {
                    bf16x8 sf[2][4];
#pragma unroll
                    for (int v2 = 0; v2 < 2; ++v2)
#pragma unroll
                        for (int ks = 0; ks < 4; ++ks) sf[v2][ks] = *(const bf16x8*)(Sb + (16 * (4 * hh + 2 * half + v2) + r16) * 136 + 32 * ks + 8 * q4);
                    __builtin_amdgcn_sched_barrier(0);
#pragma unroll
                    for (int v2 = 0; v2 < 2; ++v2) { f32x4 acc = (f32x4){0.f, 0.f, 0.f, 0.f};
#pragma unroll
                        for (int ks = 0; ks < 4; ++ks) acc = __builtin_amdgcn_mfma_f32_16x16x32_bf16(aq[ks], sf[v2][ks], acc, 0, 0, 0);
                        yst[2 * half + v2] = acc; } }
                const int i = 16 * it + r16;
#pragma unroll
                for (int jj = 0; jj < 2; ++jj) { const int jt = 2 * hh + jj; float m[4];
#pragma unroll
                    for (int r = 0; r < 4; ++r) { const int j = 16 * jt + 4 * q4 + r; m[r] = (j <= i) ? gacc[jj][r] : 0.f; }
                    u32x2 outw; outw.x = pk2(m[0], m[1]); outw.y = pk2(m[2], m[3]);
                    *(u32x2*)(Ab + (16 * it + r16) * 72 + 16 * jt + 4 * q4) = outw; }
            }
            __syncthreads();
            {
                bf16x8 aa[2], af[2], vf[8][2];
#pragma unroll
                for (int ks = 0; ks < 2; ++ks) { aa[ks] = *(const bf16x8*)(Ab + (16 * it + r16) * 72 + 32 * ks + 8 * q4); af[ks] = tr_frag(Kw, 136, 32 * ks, 16 * wave, lane); }
#pragma unroll
                for (int vt = 0; vt < 8; ++vt)
#pragma unroll
                    for (int ks = 0; ks < 2; ++ks) vf[vt][ks] = tr_frag(Vb, 136, 32 * ks, 16 * vt, lane);
                const f32x4 dec = *(const f32x4*)(decv + 16 * wave + 4 * q4);
                __builtin_amdgcn_sched_barrier(0);
#pragma unroll
                for (int vv = 0; vv < 4; ++vv) { const int vt = 4 * hh + vv; f32x4 acc = yst[vv];
#pragma unroll
                    for (int ks = 0; ks < 2; ++ks) acc = __builtin_amdgcn_mfma_f32_16x16x32_bf16(aa[ks], (hh ? vf[4 + vv][ks] : vf[vv][ks]), acc, 0, 0, 0);
#pragma unroll
                    for (int r = 0; r < 4; ++r) yb[(16 * it + 4 * q4 + r) * 128 + 16 * vt + r16] = acc[r]; }
#pragma unroll
                for (int vt = 0; vt < 8; ++vt) { Sacc[vt] = Sacc[vt] * dec;
#pragma unroll
                    for (int ks = 0; ks < 2; ++ks) Sacc[vt] = __builtin_amdgcn_mfma_f32_16x16x32_bf16(af[ks], vf[vt][ks], Sacc[vt], 0, 0, 0);
                    u32x2 w; w.x = pk2(Sacc[vt][0], Sacc[vt][1]); w.y = pk2(Sacc[vt][2], Sacc[vt][3]);
                    *(u32x2*)(Sb + (16 * vt + r16) * 136 + 16 * wave + 4 * q4) = w; }
            }
            __syncthreads();
            { const int t = dir ? (SEQ - 1 - (bt * 64 + si)) : (bt * 64 + si); u16* dst = proj + (size_t)(b * SEQ + t) * PLD + 1024 + dir * 1024 + 128 * h + c16;
                float f[16];
#pragma unroll
                for (int j = 0; j < 16; ++j) f[j] = yb[si * 128 + c16 + j];
                if (!dry) { *(u32x4*)dst = pack8(f); *(u32x4*)(dst + 8) = pack8(f + 8); } }
        }
    }
}
__device__ __forceinline__ void hgrn_norm_phase(const Args& A) {
    const int tid = threadIdx.x, lane = tid & 63, wave = tid >> 6; u16* proj = (u16*)(A.ws + WS_PROJ);
    float nw[16];
#pragma unroll
    for (int j = 0; j < 16; ++j) nw[j] = A.in[16][16 * lane + j];
    const int stride = gridDim.x * 8;
    for (int row0 = blockIdx.x * 8 + wave; row0 < NTOK; row0 += 2 * stride) {
        u32x4 raw[2][6];
#pragma unroll
        for (int rr = 0; rr < 2; ++rr) { const u16* p = proj + (size_t)(row0 + rr * stride) * PLD + 16 * lane;
            raw[rr][0] = *(const u32x4*)(p + 1024); raw[rr][1] = *(const u32x4*)(p + 1032); raw[rr][2] = *(const u32x4*)(p + 2048); raw[rr][3] = *(const u32x4*)(p + 2056);
            raw[rr][4] = *(const u32x4*)(p + 4096); raw[rr][5] = *(const u32x4*)(p + 4104); }
#pragma unroll
        for (int rr = 0; rr < 2; ++rr) { u16* p = proj + (size_t)(row0 + rr * stride) * PLD + 16 * lane; float f[16], g[16];
            unpack8(raw[rr][0], f); unpack8(raw[rr][1], f + 8); unpack8(raw[rr][2], g); unpack8(raw[rr][3], g + 8);
            float s2 = 0.f;
#pragma unroll
            for (int j = 0; j < 16; ++j) { f[j] += g[j]; s2 += f[j] * f[j]; }
            s2 += __shfl_xor(s2, 1); s2 += __shfl_xor(s2, 2); s2 += __shfl_xor(s2, 4);
            const float rs = rsqrtf(s2 * (1.0f / 128.0f) + EPS);
            unpack8(raw[rr][4], g); unpack8(raw[rr][5], g + 8);
#pragma unroll
            for (int j = 0; j < 16; ++j) f[j] = f[j] * rs * nw[j] * siluf_(g[j]);
            *(u32x4*)p = pack8(f); *(u32x4*)(p + 8) = pack8(f + 8); }
    }
}
__device__ __forceinline__ void final_norm_phase(const Args& A) {
    const u16* xb = (const u16*)(A.ws + WS_XB); const float* ss4 = (const float*)(A.ws + WS_SSP) + (size_t)3 * NTOK * 16; float* out = A.out; const float* nf = A.in[22];
    const int c8 = (threadIdx.x & 127) * 8;
    const f32x4 g0 = *(const f32x4*)(nf + c8), g1 = *(const f32x4*)(nf + c8 + 4);
    for (int row = blockIdx.x * 4 + (threadIdx.x >> 7); row < NTOK; row += gridDim.x * 8) {
        const u32x4 r0 = *(const u32x4*)(xb + (size_t)row * DM + c8); const int row2 = (row + (int)gridDim.x * 4 < NTOK) ? row + (int)gridDim.x * 4 : row; const u32x4 r1 = *(const u32x4*)(xb + (size_t)row2 * DM + c8);
        float s0, s1;
        { const f32x4 p0 = *(const f32x4*)(ss4 + (size_t)row * 16), p1 = *(const f32x4*)(ss4 + (size_t)row * 16 + 4), p2 = *(const f32x4*)(ss4 + (size_t)row * 16 + 8), p3 = *(const f32x4*)(ss4 + (size_t)row * 16 + 12);
            s0 = ((((p0[0] + p0[1]) + (p0[2] + p0[3])) + ((p1[0] + p1[1]) + (p1[2] + p1[3]))) + (((p2[0] + p2[1]) + (p2[2] + p2[3])) + ((p3[0] + p3[1]) + (p3[2] + p3[3])))); }
        { const f32x4 p0 = *(const f32x4*)(ss4 + (size_t)row2 * 16), p1 = *(const f32x4*)(ss4 + (size_t)row2 * 16 + 4), p2 = *(const f32x4*)(ss4 + (size_t)row2 * 16 + 8), p3 = *(const f32x4*)(ss4 + (size_t)row2 * 16 + 12);
            s1 = ((((p0[0] + p0[1]) + (p0[2] + p0[3])) + ((p1[0] + p1[1]) + (p1[2] + p1[3]))) + (((p2[0] + p2[1]) + (p2[2] + p2[3])) + ((p3[0] + p3[1]) + (p3[2] + p3[3])))); }
        float f[8]; unpack8(r0, f); float rs = rsqrtf(s0 * (1.0f / 1024.0f) + EPS);
        *(f32x4*)(out + (size_t)row * DM + c8) = (f32x4){f[0], f[1], f[2], f[3]} * rs * g0; *(f32x4*)(out + (size_t)row * DM + c8 + 4) = (f32x4){f[4], f[5], f[6], f[7]} * rs * g1;
        unpack8(r1, f); rs = rsqrtf(s1 * (1.0f / 1024.0f) + EPS);
        *(f32x4*)(out + (size_t)row2 * DM + c8) = (f32x4){f[0], f[1], f[2], f[3]} * rs * g0; *(f32x4*)(out + (size_t)row2 * DM + c8 + 4) = (f32x4){f[4], f[5], f[6], f[7]} * rs * g1;
    }
}

#define XB_TMO      128
#define XB_XCNT(j)  (256  + 64 * (j))
#define XB_XSUB(j)  (1280 + 64 * (j))
#define XB_XGEN(j)  (2304 + 64 * (j))
#define XB_TOP      3328
#define XB_TOPGEN   3392
#define XCD_BAR_WORDS 3456
#define XB_SPIN_CAP (1u << 18)
__device__ __forceinline__ unsigned xb_ld(unsigned* p)              { return __hip_atomic_load(p, __ATOMIC_RELAXED, __HIP_MEMORY_SCOPE_AGENT); }
__device__ __forceinline__ unsigned xb_add(unsigned* p, unsigned v) { return __hip_atomic_fetch_add(p, v, __ATOMIC_RELAXED, __HIP_MEMORY_SCOPE_AGENT); }
__device__ __forceinline__ unsigned xb_xcc_id() { return (unsigned)__builtin_amdgcn_s_getreg((3 << 11) | 20) & 0xFu; }
#define XB_SPIN(cond, bar) do { unsigned _sp = 0; while (cond) { __builtin_amdgcn_s_sleep(1); \
    if ((++_sp & 255u) == 0u) { if (xb_ld(&(bar)[XB_TMO])) break; if (_sp > XB_SPIN_CAP) { atomicAdd(&(bar)[XB_TMO], 1u); break; } } } } while (0)
struct XcdBarrier { unsigned* bar; unsigned x; volatile LAS unsigned* st; };
__device__ __forceinline__ XcdBarrier xcd_barrier_post(unsigned* bar, volatile LAS unsigned* st) {
    XcdBarrier b; b.bar = bar; b.x = xb_xcc_id(); b.st = st;
    if (threadIdx.x == 0) (void)xb_add(&bar[XB_XCNT(b.x)], 1u);
    return b;
}
__device__ __forceinline__ void xcd_barrier_complete(unsigned* bar, unsigned x, unsigned& nloc, unsigned& nx) {
    const unsigned G = gridDim.x * gridDim.y * gridDim.z;
    unsigned sum, cnt, mine, sp = 0u;
    for (;;) {
        sum = 0u; cnt = 0u; mine = 0u;
#pragma unroll
        for (unsigned j = 0; j < 16; ++j) { const unsigned c = xb_ld(&bar[XB_XCNT(j)]); sum += c; cnt += (c > 0u) ? 1u : 0u; mine = (j == x) ? c : mine; }
        if (sum == G) break;
        __builtin_amdgcn_s_sleep(1);
        if ((++sp & 255u) == 0u) { if (xb_ld(&bar[XB_TMO])) break; if (sp > XB_SPIN_CAP) { atomicAdd(&bar[XB_TMO], 1u); break; } }
    }
    nloc = mine > 0u ? mine : 1u; nx = cnt > 0u ? cnt : 1u;
}
__device__ __forceinline__ void xcd_barrier(const XcdBarrier& b) {
    asm volatile("s_waitcnt vmcnt(0)" ::: "memory");
    __syncthreads();
    if (threadIdx.x == 0) {
        unsigned* bar = b.bar;
        __builtin_amdgcn_s_waitcnt(0);
        unsigned nloc = b.st[0], nx = b.st[1];
        if (nloc == 0u) { xcd_barrier_complete(bar, b.x, nloc, nx); b.st[0] = nloc; b.st[1] = nx; }
        const unsigned old = xb_add(&bar[XB_XSUB(b.x)], 1u);
        const unsigned gen = old / nloc;
        if (old + 1u == (gen + 1u) * nloc) {
            __builtin_amdgcn_fence(__ATOMIC_RELEASE, "agent");
            asm volatile("s_waitcnt vmcnt(0)" ::: "memory");
            const unsigned og = xb_add(&bar[XB_TOP], 1u);
            const unsigned tg = og / nx;
            if (og + 1u == (tg + 1u) * nx) xb_add(&bar[XB_TOPGEN], 1u);
            else XB_SPIN(xb_ld(&bar[XB_TOPGEN]) == tg, bar);
            __builtin_amdgcn_fence(__ATOMIC_ACQUIRE, "agent");
            xb_add(&bar[XB_XGEN(b.x)], 1u);
            asm volatile("s_waitcnt vmcnt(0)" ::: "memory");
        } else {
            XB_SPIN(xb_ld(&bar[XB_XGEN(b.x)]) == gen, bar);
            __builtin_amdgcn_fence(__ATOMIC_ACQUIRE, "agent");
            asm volatile("s_waitcnt vmcnt(0)" ::: "memory");
        }
    }
    __syncthreads();
}

__device__ __forceinline__ void conv_halo(const u16* proj, u32x4* hbuf, int id) {
    if (id < 16 * 64 * 384) { const int oc = id % 384, sg = (id / 384) & 63, b = id / (384 * 64); const int t0 = sg * 64;
        const u16* base = proj + (size_t)(b * SEQ) * PLD + 8 * oc; u32x4 h0 = (u32x4){0u, 0u, 0u, 0u}, h1 = h0, h2 = h0;
        if (t0 > 0) h0 = *(const u32x4*)(base + (size_t)(t0 - 1) * PLD);
        if (t0 + 64 < SEQ) { h1 = *(const u32x4*)(base + (size_t)(t0 + 64) * PLD); h2 = *(const u32x4*)(base + (size_t)(t0 + 65) * PLD); }
        hbuf[(size_t)id * 3] = h0; hbuf[(size_t)id * 3 + 1] = h1; hbuf[(size_t)id * 3 + 2] = h2; }
}
template <bool ACT> __device__ __forceinline__ void conv_batch(u16* base, int eb, const u32x4 (&rw)[8], float (&win)[4][8], const float (&wk)[4][8], const float (&bs)[8]) {
#pragma unroll
    for (int j = 0; j < 8; ++j) { unpack8(rw[j], win[(j + 3) & 3]);
        float acc[8];
#pragma unroll
        for (int c = 0; c < 8; ++c) { float a = bs[c];
#pragma unroll
            for (int kk = 0; kk < 4; ++kk) a += wk[kk][c] * win[(j + kk) & 3][c];
            acc[c] = ACT ? siluf_(a) : a; }
        *(u32x4*)(base + (size_t)(eb + j) * PLD) = pack8(acc); }
}
template <bool ACT> __device__ __forceinline__ void conv_sweep_t(u16* base, const float* conv_w, const float* conv_b, int oc, const u32x4 h0, const u32x4 h1, const u32x4 h2) {
    float wk[4][8], bs[8];
#pragma unroll
    for (int kk = 0; kk < 4; ++kk) { const f32x4 a0 = *(const f32x4*)(conv_w + kk * 3072 + 8 * oc), a1 = *(const f32x4*)(conv_w + kk * 3072 + 8 * oc + 4);
        wk[kk][0] = a0[0]; wk[kk][1] = a0[1]; wk[kk][2] = a0[2]; wk[kk][3] = a0[3]; wk[kk][4] = a1[0]; wk[kk][5] = a1[1]; wk[kk][6] = a1[2]; wk[kk][7] = a1[3]; }
    { const f32x4 a0 = *(const f32x4*)(conv_b + 8 * oc), a1 = *(const f32x4*)(conv_b + 8 * oc + 4);
        bs[0] = a0[0]; bs[1] = a0[1]; bs[2] = a0[2]; bs[3] = a0[3]; bs[4] = a1[0]; bs[5] = a1[1]; bs[6] = a1[2]; bs[7] = a1[3]; }
    float win[4][8];
    unpack8(h0, win[0]); unpack8(*(const u32x4*)(base), win[1]); unpack8(*(const u32x4*)(base + PLD), win[2]);
    u32x4 ra[8], rb[8];
#pragma unroll
    for (int j = 0; j < 8; ++j) ra[j] = *(const u32x4*)(base + (size_t)(2 + j) * PLD);
#pragma unroll 1
    for (int eb = 0; eb < 48; eb += 16) {
#pragma unroll
        for (int j = 0; j < 8; ++j) rb[j] = *(const u32x4*)(base + (size_t)(eb + 10 + j) * PLD);
        conv_batch<ACT>(base, eb, ra, win, wk, bs);
#pragma unroll
        for (int j = 0; j < 8; ++j) ra[j] = *(const u32x4*)(base + (size_t)(eb + 18 + j) * PLD);
        conv_batch<ACT>(base, eb + 8, rb, win, wk, bs);
    }
#pragma unroll
    for (int j = 0; j < 6; ++j) rb[j] = *(const u32x4*)(base + (size_t)(58 + j) * PLD);
    rb[6] = h1; rb[7] = h2;
    conv_batch<ACT>(base, 48, ra, win, wk, bs);
    conv_batch<ACT>(base, 56, rb, win, wk, bs);
}
__device__ __forceinline__ void conv_sweep(u16* proj, const float* conv_w, const float* conv_b, const u32x4* hbuf, int id) {
    if (id >= 16 * 64 * 384) return;
    const u32x4 h0 = hbuf[(size_t)id * 3], h1 = hbuf[(size_t)id * 3 + 1], h2 = hbuf[(size_t)id * 3 + 2];
    const int oc = id % 384, sg = (id / 384) & 63, b = id / (384 * 64); const int t0 = sg * 64;
    u16* base = proj + (size_t)(b * SEQ + t0) * PLD + 8 * oc;
    if (oc < 256) conv_sweep_t<true>(base, conv_w, conv_b, oc, h0, h1, h2);
    else conv_sweep_t<false>(base, conv_w, conv_b, oc, h0, h1, h2);
}
__device__ __forceinline__ void conv_phase(const Args& A, const XcdBarrier& xbar) {
    u16* proj = (u16*)(A.ws + WS_PROJ); const float* conv_w = A.in[2]; const float* conv_b = A.in[3];
    const int nthr = gridDim.x * 512, gt = blockIdx.x * 512 + threadIdx.x;
    u32x4* hbuf = (u32x4*)(A.ws + WS_HALO);
    conv_halo(proj, hbuf, gt); conv_halo(proj, hbuf, gt + nthr); conv_halo(proj, hbuf, gt + 2 * nthr);
    xcd_barrier(xbar);
    conv_sweep(proj, conv_w, conv_b, hbuf, gt);
    asm volatile("" ::: "memory");
    conv_sweep(proj, conv_w, conv_b, hbuf, gt + nthr);
    asm volatile("" ::: "memory");
    conv_sweep(proj, conv_w, conv_b, hbuf, gt + 2 * nthr);
}

constexpr int NPHASE = 15;
template <bool COOP>
__global__ void __launch_bounds__(512, 2) mega(Args A) {
    extern __shared__ __attribute__((aligned(16))) unsigned char smem[];
    LAS unsigned char* lds = (LAS unsigned char*)smem;
    unsigned char* ws = A.ws; const int G = gridDim.x, c = blockIdx.x;
    float* ss = (float*)(ws + WS_SS); float* ssp = (float*)(ws + WS_SSP); u16* xb = (u16*)(ws + WS_XB); u16* proj = (u16*)(ws + WS_PROJ); float* dt = (float*)(ws + WS_DT);
#define IN(k) (A.lo <= (k) && (k) < A.hi)
    XcdBarrier xbar; xbar.bar = (unsigned*)(ws + WS_BAR); xbar.x = 0; xbar.st = (volatile LAS unsigned*)(lds + 131072);
    if (COOP) { if (threadIdx.x < 4) ((LAS unsigned*)(lds + 131072))[threadIdx.x] = 0u;
        if (blockIdx.x == 0 && threadIdx.x < 51) { const int i_ = threadIdx.x;
            const int w_ = i_ < 16 ? XB_XCNT(i_) : (i_ < 32 ? XB_XSUB(i_ - 16) : (i_ < 48 ? XB_XGEN(i_ - 32) : (i_ == 48 ? XB_TOP : (i_ == 49 ? XB_TOPGEN : XB_TMO))));
            __hip_atomic_store((unsigned*)(ws + WS_BAR) + w_, 0u, __ATOMIC_RELAXED, __HIP_MEMORY_SCOPE_AGENT); }
        __syncthreads(); }
#define SEAM(k) do { if (COOP && IN(k) && IN((k) + 1)) { if ((k) == 0) { cg::this_grid().sync(); xbar = xcd_barrier_post((unsigned*)(ws + WS_BAR), (volatile LAS unsigned*)(lds + 131072)); } else xcd_barrier(xbar); } } while (0)
    if (IN(0)) prep_phase(A, smem);
    SEAM(0);
    if (IN(1)) { pg8::Gemm g{xb, (const u16*)(ws + WS_WIN0), NTOK, 5376, 1024, 1024}; pg8::StaticOrder S; S.init(NTOK, 5376, G, c);
        pg8::EpiScale<0, true, 1> E{proj, PLD, ss, dt}; pg8::gemm_phase(lds, g, S, E); }
    SEAM(1);
    if (IN(2)) conv_phase(A, xbar);
    SEAM(2);
    if (IN(3)) { ssd_phase(A, smem, false); lru_phase(A, smem, false); }
    SEAM(3);
    if (IN(4)) ssd_norm_phase(A);
    SEAM(4);
    if (IN(5)) { pg8::Gemm g{proj + 3072, (const u16*)(ws + WS_WOUT0), NTOK, 1024, 2048, PLD}; pg8::StaticOrder S; S.init(NTOK, 1024, G, c);
        pg8::EpiResid<false> E{xb, A.out, ssp}; pg8::gemm_phase(lds, g, S, E); }
    SEAM(5);
    if (IN(6)) { pg8::Gemm g{xb, (const u16*)(ws + WS_WUP0), NTOK, 4096, 1024, 1024}; pg8::StaticOrder S; S.init(NTOK, 4096, G, c);
        pg8::EpiScale<1, false, 16> E{proj, 4096, ssp, nullptr}; pg8::gemm_phase(lds, g, S, E); }
    SEAM(6);
    if (IN(7)) { pg8::Gemm g{proj, (const u16*)(ws + WS_WDN0), NTOK, 1024, 4096, 4096}; pg8::StaticOrder S; S.init(NTOK, 1024, G, c);
        pg8::EpiResid<false> E{xb, A.out, ssp + (size_t)NTOK * 16}; pg8::gemm_phase(lds, g, S, E); }
    SEAM(7);
    if (IN(8)) { pg8::Gemm g{xb, (const u16*)(ws + WS_WIN1), NTOK, 5120, 1024, 1024}; pg8::StaticOrder S; S.init(NTOK, 5120, G, c);
        pg8::EpiScale<0, false, 16> E{proj, PLD, ssp + (size_t)NTOK * 16, nullptr}; pg8::gemm_phase(lds, g, S, E); }
    SEAM(8);
    if (IN(9)) { hgrn_phase(A, smem, false); }
    SEAM(9);
    if (IN(10)) hgrn_norm_phase(A);
    SEAM(10);
    if (IN(11)) { pg8::Gemm g{proj, (const u16*)(ws + WS_WOUT1), NTOK, 1024, 1024, PLD}; pg8::StaticOrder S; S.init(NTOK, 1024, G, c);
        pg8::EpiResid<false> E{xb, A.out, ssp + (size_t)2 * NTOK * 16}; pg8::gemm_phase(lds, g, S, E); }
    SEAM(11);
    if (IN(12)) { pg8::Gemm g{xb, (const u16*)(ws + WS_WUP1), NTOK, 4096, 1024, 1024}; pg8::StaticOrder S; S.init(NTOK, 4096, G, c);
        pg8::EpiScale<1, false, 16> E{proj, 4096, ssp + (size_t)2 * NTOK * 16, nullptr}; pg8::gemm_phase(lds, g, S, E); }
    SEAM(12);
    if (IN(13)) { pg8::Gemm g{proj, (const u16*)(ws + WS_WDN1), NTOK, 1024, 4096, 4096}; pg8::StaticOrder S; S.init(NTOK, 1024, G, c);
        pg8::EpiResid<false> E{xb, A.out, ssp + (size_t)3 * NTOK * 16}; pg8::gemm_phase(lds, g, S, E); }
    SEAM(13);
    if (IN(14)) final_norm_phase(A);
#undef IN
#undef SEAM
}

#ifndef PROBE_MASK
#define PROBE_MASK 0
#endif
#ifndef N_LAUNCH_MODE
#define N_LAUNCH_MODE 1
#endif

extern "C" void kernel_launch(void* const* d_in, const int* in_sizes, int n_in, void* d_out, int out_size, void* d_ws, size_t ws_size, hipStream_t stream) {
    static int grid = 0;
    if (grid == 0) {
        if (n_in != 23 || out_size != NTOK * DM || ws_size < WS_END) { fprintf(stderr, "kernel_launch: unexpected shapes (n_in %d out %d ws %zu need %zu)\n", n_in, out_size, ws_size, (size_t)WS_END); grid = -1; return; }
        int dev = 0, cus = 0, per_cu = 0;
        (void)hipGetDevice(&dev); (void)hipDeviceGetAttribute(&cus, hipDeviceAttributeMultiprocessorCount, dev);
        (void)hipFuncSetAttribute((const void*)mega<true>, hipFuncAttributeMaxDynamicSharedMemorySize, LDS_BYTES);
#if N_LAUNCH_MODE != 1
        (void)hipFuncSetAttribute((const void*)mega<false>, hipFuncAttributeMaxDynamicSharedMemorySize, LDS_BYTES);
#endif
        (void)hipOccupancyMaxActiveBlocksPerMultiprocessor(&per_cu, (const void*)mega<true>, 512, LDS_BYTES);
        if (per_cu < 1) per_cu = 1;
        (void)hipGetLastError();
        grid = cus * per_cu;
        if (grid <= 0) grid = 256;
    }
    if (grid < 0) return;
    Args a{};
    for (int i = 0; i < 23; ++i) a.in[i] = (const float*)d_in[i];
    a.out = (float*)d_out; a.ws = (unsigned char*)d_ws; a.probe = PROBE_MASK;
#if N_LAUNCH_MODE == 1
    a.lo = 0; a.hi = NPHASE;
    void* args[] = {&a};
    hipError_t e = hipLaunchCooperativeKernel((const void*)mega<true>, dim3(grid), dim3(512), args, LDS_BYTES, stream);
    if (e != hipSuccess) fprintf(stderr, "cooperative launch failed: %s (grid %d)\n", hipGetErrorString(e), grid);
#else
    for (int k = 0; k < NPHASE; ++k) { a.lo = k; a.hi = k + 1; mega<false><<<grid, 512, LDS_BYTES, stream>>>(a); }
#endif
}
```

```cpp
#include <hip/hip_runtime.h>
#include <hip/hip_cooperative_groups.h>
#include <cstdio>
namespace cg = cooperative_groups;

#ifndef GEMM_STAGGER
#define GEMM_STAGGER 0
#endif
#ifndef TR_GATHER
#define TR_GATHER 0
#endif
#define LAS __attribute__((address_space(3)))
typedef unsigned short u16;
typedef short bf16x8 __attribute__((ext_vector_type(8)));
typedef float f32x4 __attribute__((ext_vector_type(4)));
typedef float f32x2 __attribute__((ext_vector_type(2)));
typedef unsigned u32x4 __attribute__((ext_vector_type(4)));
typedef unsigned u32x2 __attribute__((ext_vector_type(2)));

constexpr int NTOK = 65536, DM = 1024, SEQ = 4096;
constexpr int PLD = 5120;
constexpr int LDS_BYTES = 131072 + 16;
constexpr float EPS = 1e-6f;

constexpr size_t WS_WIN0 = 0;
constexpr size_t WS_WOUT0 = WS_WIN0 + (size_t)5376 * 1024 * 2;
constexpr size_t WS_WUP0 = WS_WOUT0 + (size_t)1024 * 2048 * 2;
constexpr size_t WS_WUP1 = WS_WUP0 + (size_t)4096 * 1024 * 2;
constexpr size_t WS_WDN0 = WS_WUP1 + (size_t)4096 * 1024 * 2;
constexpr size_t WS_WDN1 = WS_WDN0 + (size_t)4096 * 1024 * 2;
constexpr size_t WS_WIN1 = WS_WDN1 + (size_t)4096 * 1024 * 2;
constexpr size_t WS_WOUT1 = WS_WIN1 + (size_t)5120 * 1024 * 2;
constexpr size_t WS_SS = WS_WOUT1 + (size_t)1024 * 1024 * 2;
constexpr size_t WS_DT = WS_SS + (size_t)5 * NTOK * 4;
constexpr size_t WS_XB = WS_DT + (size_t)NTOK * 32 * 4;
constexpr size_t WS_TMP2 = WS_XB + (size_t)NTOK * 1024 * 2;
constexpr size_t WS_PROJ = WS_TMP2 + (size_t)NTOK * 1024 * 2;
constexpr size_t WS_BAR = WS_PROJ + (size_t)NTOK * PLD * 2;
constexpr size_t WS_SSP = WS_BAR + 16384;
constexpr size_t WS_HALO = WS_SSP + (size_t)4 * NTOK * 16 * 4;
constexpr size_t WS_END = WS_HALO + (size_t)16 * 64 * 384 * 48;

struct Args { const float* in[23]; float* out; unsigned char* ws; int lo, hi, probe, pad; };

__device__ __forceinline__ float bf_lo(unsigned w) { return __uint_as_float(w << 16); }
__device__ __forceinline__ float bf_hi(unsigned w) { return __uint_as_float(w & 0xffff0000u); }
__device__ __forceinline__ float bf2f(u16 b) { return __uint_as_float(((unsigned)b) << 16); }
__device__ __forceinline__ u16 f2bf(float f) { unsigned u = __float_as_uint(f); u += 0x7FFFu + ((u >> 16) & 1u); return (u16)(u >> 16); }
typedef __bf16 bf16x2_t __attribute__((ext_vector_type(2)));
__device__ __forceinline__ unsigned pk2(float lo, float hi) { const f32x2 v = (f32x2){lo, hi}; const bf16x2_t b = __builtin_convertvector(v, bf16x2_t); return __builtin_bit_cast(unsigned, b); }
__device__ __forceinline__ void unpack8(const u32x4 v, float* f) { f[0] = bf_lo(v.x); f[1] = bf_hi(v.x); f[2] = bf_lo(v.y); f[3] = bf_hi(v.y); f[4] = bf_lo(v.z); f[5] = bf_hi(v.z); f[6] = bf_lo(v.w); f[7] = bf_hi(v.w); }
__device__ __forceinline__ u32x4 pack8(const float* f) { u32x4 w; w.x = pk2(f[0], f[1]); w.y = pk2(f[2], f[3]); w.z = pk2(f[4], f[5]); w.w = pk2(f[6], f[7]); return w; }
__device__ __forceinline__ float sigmoidf_(float x) { return __builtin_amdgcn_rcpf(1.0f + __expf(-x)); }
__device__ __forceinline__ float siluf_(float x) { return x * __builtin_amdgcn_rcpf(1.0f + __expf(-x)); }
__device__ __forceinline__ float gelu_tanh(float x) { const float v = 0.7978845608028654f * (x + 0.044715f * x * x * x); const float th = 1.0f - 2.0f * __builtin_amdgcn_rcpf(__expf(2.0f * v) + 1.0f); return 0.5f * x * (1.0f + th); }

namespace pg8 {
constexpr int BM = 256, BK = 64, HALF = 128, HTB = HALF * BK * 2, STAGE_BYTES = 8 * HTB, NXCD = 8, WGM = 8;
__host__ __device__ __forceinline__ int lds_byte(int r, int c) { const int st = (r >> 4) * 2 + (c >> 5), rr = r & 15, cc = c & 31, ob = rr * 64 + cc * 2; return st * 1024 + (ob ^ (((ob >> 9) & 1) << 5)); }
__host__ __device__ __forceinline__ void stage_rc(int b, int& R, int& C) { const int st = b / 1024, sb = b % 1024, swz = sb ^ (((sb >> 9) & 1) << 5); R = (st >> 1) * 16 + swz / 64; C = (st & 1) * 32 + (swz % 64) / 2; }
__host__ __device__ __forceinline__ int perm32(int rho) { const int n = rho >> 4, i = rho & 15; return 8 * (i >> 2) + 4 * n + (i & 3); }
struct Unit { int pm, pn; };
struct Gemm { const u16* A; const u16* Bt; int M, N, K, lda; };
struct StaticOrder {
    int nM, nN, nwg, G, c;
    __device__ void init(int M, int N, int G_, int c_) { nM = M / BM; nN = N / BM; nwg = nM * nN; G = G_; c = c_; }
    __device__ bool next(int i, Unit& u) const {
        const long L = (long)i * G + c; if (L >= nwg) return false;
        int wgid = (int)L; { const int q = nwg / NXCD, r = nwg % NXCD, xcd = wgid % NXCD, off = wgid / NXCD; wgid = (xcd < r ? xcd * (q + 1) : r * (q + 1) + (xcd - r) * q) + off; }
        const int nig = WGM * nN, gid = wgid / nig, fm = gid * WGM, gsz = (nM - fm) < WGM ? (nM - fm) : WGM;
        u.pm = fm + ((wgid % nig) % gsz); u.pn = (wgid % nig) / gsz; return true;
    }
};

template <int ACT, bool DT, int SLOTS> struct EpiScale {
    static constexpr bool PERM = true;
    u16* O; int ldc; const float* ss; float* dt;
    __device__ __forceinline__ void pre(const Unit&, int, int, float (&)[8]) const {}
    __device__ __forceinline__ void operator()(const f32x4 (&acc)[2][2][4][2], const Unit& u, int wr, int wc, int fr, int fq, const float (&)[8]) const {
        const int row0 = u.pm * BM + wr * 64 + fr;
        float ep[8];
#pragma unroll
        for (int ai = 0; ai < 2; ++ai)
#pragma unroll
            for (int m = 0; m < 4; ++m) { const int row = row0 + ai * HALF + m * 16;
                if (SLOTS == 1) ep[ai * 4 + m] = ss[row];
                else { const f32x4 pq = *(const f32x4*)(ss + (size_t)row * 16 + 4 * fq); ep[ai * 4 + m] = (pq[0] + pq[1]) + (pq[2] + pq[3]); } }
        if (SLOTS != 1) {
#pragma unroll
            for (int q = 0; q < 8; ++q) { ep[q] += __shfl_xor(ep[q], 16); ep[q] += __shfl_xor(ep[q], 32); } }
        if (DT && u.pn == 20) {
            if (wc == 0) {
#pragma unroll
                for (int ai = 0; ai < 2; ++ai)
#pragma unroll
                    for (int m = 0; m < 4; ++m) { const int row = row0 + ai * HALF + m * 16; const float rs = rsqrtf(ep[ai * 4 + m] * (1.0f / 1024.0f) + EPS);
                        *(f32x4*)(dt + (size_t)row * 32 + 8 * fq) = acc[ai][0][m][0] * rs; *(f32x4*)(dt + (size_t)row * 32 + 8 * fq + 4) = acc[ai][0][m][1] * rs; }
            }
            return;
        }
        const int col0 = u.pn * BM + wc * 32 + 8 * fq;
#pragma unroll
        for (int ai = 0; ai < 2; ++ai)
#pragma unroll
            for (int m = 0; m < 4; ++m) { const int row = row0 + ai * HALF + m * 16; const float rs = rsqrtf(ep[ai * 4 + m] * (1.0f / 1024.0f) + EPS);
                u16* rowp = O + (size_t)row * ldc + col0;
#pragma unroll
                for (int bj = 0; bj < 2; ++bj) { f32x4 v0 = acc[ai][bj][m][0] * rs, v1 = acc[ai][bj][m][1] * rs;
                    if (ACT == 1) {
#pragma unroll
                        for (int j = 0; j < 4; ++j) { const float a0 = fmaxf(v0[j], 0.f), a1 = fmaxf(v1[j], 0.f); v0[j] = a0 * a0; v1[j] = a1 * a1; } }
                    u32x4 w; w.x = pk2(v0[0], v0[1]); w.y = pk2(v0[2], v0[3]); w.z = pk2(v1[0], v1[1]); w.w = pk2(v1[2], v1[3]);
                    *(u32x4*)(rowp + bj * HALF) = w; } }
    }
};
template <bool LAST> struct EpiResid {
    static constexpr bool PERM = true;
    u16* xb; float* out; float* ss;
    __device__ __forceinline__ void pre(const Unit&, int, int, float (&)[8]) const {}
    __device__ __forceinline__ void operator()(const f32x4 (&acc)[2][2][4][2], const Unit& u, int wr, int wc, int fr, int fq, const float (&)[8]) const {
        const int row0 = u.pm * BM + wr * 64 + fr, col0 = u.pn * BM + wc * 32 + 8 * fq;
#pragma unroll
        for (int ai = 0; ai < 2; ++ai) {
            u32x4 bv[4][2];
#pragma unroll
            for (int m = 0; m < 4; ++m)
#pragma unroll
                for (int bj = 0; bj < 2; ++bj) bv[m][bj] = *(const u32x4*)(xb + (size_t)(row0 + ai * HALF + m * 16) * DM + col0 + bj * HALF);
#pragma unroll
            for (int m = 0; m < 4; ++m) { const int row = row0 + ai * HALF + m * 16; const size_t ro = (size_t)row * DM + col0; float s = 0.f;
#pragma unroll
                for (int bj = 0; bj < 2; ++bj) { float b8[8]; unpack8(bv[m][bj], b8);
                    const f32x4 v0 = (f32x4){b8[0], b8[1], b8[2], b8[3]} + acc[ai][bj][m][0], v1 = (f32x4){b8[4], b8[5], b8[6], b8[7]} + acc[ai][bj][m][1];
                    s += v0[0] * v0[0] + v0[1] * v0[1] + v0[2] * v0[2] + v0[3] * v0[3] + v1[0] * v1[0] + v1[1] * v1[1] + v1[2] * v1[2] + v1[3] * v1[3];
                    if (LAST) { *(f32x4*)(out + ro + bj * HALF) = v0; *(f32x4*)(out + ro + bj * HALF + 4) = v1; }
                    else { u32x4 w; w.x = pk2(v0[0], v0[1]); w.y = pk2(v0[2], v0[3]); w.z = pk2(v1[0], v1[1]); w.w = pk2(v1[2], v1[3]); *(u32x4*)(xb + ro + bj * HALF) = w; } }
                s += __shfl_xor(s, 16); s += __shfl_xor(s, 32);
                if (fq == 0) ss[(size_t)row * 16 + u.pn * 4 + wc] = s; }
        }
    }
};

template <class Epi>
__device__ __forceinline__ void gemm_phase(LAS unsigned char* lds, const Gemm g, const StaticOrder& S, const Epi& E) {
    const int tid = threadIdx.x, wid = __builtin_amdgcn_readfirstlane(tid >> 6), lane = tid & 63, wr = wid >> 2, wc = wid & 3, fr = lane & 15, fq = lane >> 4;
    const int K = g.K, nt = K / BK, lda = g.lda;
    unsigned voffA[2], voffB[2];
#pragma unroll
    for (int i = 0; i < 2; ++i) { int R, C; stage_rc(tid * 16 + i * 8192, R, C); const int Rb = Epi::PERM ? ((R & ~31) + perm32(R & 31)) : R;
        voffA[i] = (unsigned)(R * lda + C) * 2u; voffB[i] = (unsigned)(Rb * K + C) * 2u; }
    const size_t kstep = (size_t)(BK * 2);
    const size_t hstepA = (size_t)HALF * lda * 2, hstepB = (size_t)HALF * K * 2;
    const size_t tstepA = 2 * hstepA, tstepB = 2 * hstepB;
    const unsigned ldsw = (unsigned)wid * 1024u;
    const int aoff = lds_byte(wr * 64 + fr, fq * 8), boff = lds_byte(wc * 32 + fr, fq * 8);
#define PG8_SA(b, h) (((b) * 2 + (h)) * HTB)
#define PG8_SB(b, h) ((4 + (b) * 2 + (h)) * HTB)
#define PG8_STAGE(bufoff, gbase, voff) do { _Pragma("unroll") for (int _i = 0; _i < 2; ++_i) \
        __builtin_amdgcn_global_load_lds((const unsigned*)((const char*)(gbase) + (voff)[_i]), (LAS unsigned*)(lds + (bufoff) + ldsw + _i * 8192), 16, 0, 0); } while (0)
#define PG8_LDA(dst, b, h) do { _Pragma("unroll") for (int m = 0; m < 4; ++m) _Pragma("unroll") for (int k = 0; k < 2; ++k) dst[m][k] = *(const LAS bf16x8*)(lds + PG8_SA(b, h) + aoff + m * 2048 + k * 1024); } while (0)
#define PG8_LDB(dst, b, h) do { _Pragma("unroll") for (int n = 0; n < 2; ++n) _Pragma("unroll") for (int k = 0; k < 2; ++k) dst[n][k] = *(const LAS bf16x8*)(lds + PG8_SB(b, h) + boff + n * 2048 + k * 1024); } while (0)
#define PG8_MMA(ai, bj, At, Bt) do { __builtin_amdgcn_s_setprio(1); _Pragma("unroll") for (int m = 0; m < 4; ++m) _Pragma("unroll") for (int n = 0; n < 2; ++n) _Pragma("unroll") for (int k = 0; k < 2; ++k) \
        acc[ai][bj][m][n] = __builtin_amdgcn_mfma_f32_16x16x32_bf16(Bt[n][k], At[m][k], acc[ai][bj][m][n], 0, 0, 0); __builtin_amdgcn_s_setprio(0); } while (0)
#define PG8_WAIT_V(n) asm volatile("s_waitcnt vmcnt(" #n ")" ::: "memory")
#define PG8_WAIT_L(n) asm volatile("s_waitcnt lgkmcnt(" #n ")" ::: "memory")
#define PG8_BAR __builtin_amdgcn_s_barrier()
#define PG8_SCHED __builtin_amdgcn_sched_barrier(0)
    Unit cur, nxt; int ui = 0;
    if (!S.next(0, cur)) return;
#if GEMM_STAGGER
    for (int q_ = 0; q_ < ((S.c >> 3) & 3); ++q_) __builtin_amdgcn_s_sleep(100);
#endif
    f32x4 acc[2][2][4][2];
#pragma unroll
    for (int a = 0; a < 2; ++a)
#pragma unroll
        for (int b = 0; b < 2; ++b)
#pragma unroll
            for (int m = 0; m < 4; ++m)
#pragma unroll
                for (int n = 0; n < 2; ++n) acc[a][b][m][n] = (f32x4){0.f, 0.f, 0.f, 0.f};
    bf16x8 At[4][2], B0[2][2], B1[2][2]; float epre[8];
#pragma unroll
    for (int q_ = 0; q_ < 8; ++q_) epre[q_] = 0.f;
    const char* cA = (const char*)g.A + (size_t)cur.pm * tstepA; const char* cB = (const char*)g.Bt + (size_t)cur.pn * tstepB;
    PG8_STAGE(PG8_SB(0, 0), cB, voffB); PG8_STAGE(PG8_SA(0, 0), cA, voffA); PG8_STAGE(PG8_SB(0, 1), cB + hstepB, voffB); PG8_STAGE(PG8_SA(0, 1), cA + hstepA, voffA);
    if (wr == 1) PG8_BAR;
    PG8_WAIT_V(4); PG8_BAR;
    PG8_STAGE(PG8_SB(1, 0), cB + kstep, voffB); PG8_STAGE(PG8_SA(1, 0), cA + kstep, voffA); PG8_STAGE(PG8_SB(1, 1), cB + hstepB + kstep, voffB);
    PG8_WAIT_V(6); PG8_BAR;
    for (;;) {
        const bool has_next = S.next(ui + 1, nxt);
        const char* nA = has_next ? (const char*)g.A + (size_t)nxt.pm * tstepA : cA; const char* nB = has_next ? (const char*)g.Bt + (size_t)nxt.pn * tstepB : cB;
        for (int t = 0; t < nt; t += 2) {
            const bool last = (t == nt - 2);
            const char* a1 = cA + (size_t)(t + 1) * kstep;
            const char* a2 = last ? nA : cA + (size_t)(t + 2) * kstep; const char* b2 = last ? nB : cB + (size_t)(t + 2) * kstep;
            const char* a3 = a2 + kstep; const char* b3 = b2 + kstep;
            if (last) E.pre(cur, wr, fr, epre);
            PG8_LDB(B0, 0, 0); PG8_SCHED; PG8_LDA(At, 0, 0); PG8_STAGE(PG8_SA(1, 1), a1 + hstepA, voffA);
            PG8_WAIT_L(8); PG8_BAR; PG8_WAIT_L(0); PG8_MMA(0, 0, At, B0); PG8_BAR; PG8_SCHED;
            PG8_LDB(B1, 0, 1); PG8_STAGE(PG8_SB(0, 0), b2, voffB);
            PG8_BAR; PG8_WAIT_L(0); PG8_MMA(0, 1, At, B1); PG8_BAR;
            PG8_LDA(At, 0, 1); PG8_STAGE(PG8_SA(0, 0), a2, voffA);
            PG8_BAR; PG8_WAIT_L(0); PG8_MMA(1, 0, At, B0); PG8_BAR; PG8_SCHED;
            PG8_STAGE(PG8_SB(0, 1), b2 + hstepB, voffB);
            PG8_WAIT_V(6); PG8_BAR; PG8_MMA(1, 1, At, B1); PG8_BAR;
            PG8_LDB(B0, 1, 0); PG8_SCHED; PG8_LDA(At, 1, 0); PG8_STAGE(PG8_SA(0, 1), a2 + hstepA, voffA);
            PG8_WAIT_L(8); PG8_BAR; PG8_WAIT_L(0); PG8_MMA(0, 0, At, B0); PG8_BAR; PG8_SCHED;
            PG8_LDB(B1, 1, 1); PG8_STAGE(PG8_SB(1, 0), b3, voffB);
            PG8_BAR; PG8_WAIT_L(0); PG8_MMA(0, 1, At, B1); PG8_BAR;
            PG8_LDA(At, 1, 1); PG8_STAGE(PG8_SA(1, 0), a3, voffA);
            PG8_BAR; PG8_WAIT_L(0); PG8_MMA(1, 0, At, B0); PG8_BAR; PG8_SCHED;
            PG8_STAGE(PG8_SB(1, 1), b3 + hstepB, voffB);
            PG8_WAIT_V(6); PG8_BAR; PG8_MMA(1, 1, At, B1); PG8_BAR;
        }
        E(acc, cur, wr, wc, fr, fq, epre);
        if (!has_next) break;
#pragma unroll
        for (int a = 0; a < 2; ++a)
#pragma unroll
            for (int b = 0; b < 2; ++b)
#pragma unroll
                for (int m = 0; m < 4; ++m)
#pragma unroll
                    for (int n = 0; n < 2; ++n) acc[a][b][m][n] = (f32x4){0.f, 0.f, 0.f, 0.f};
        cur = nxt; cA = nA; cB = nB; ++ui;
    }
    PG8_WAIT_V(0);
    if (wr == 0) PG8_BAR;
    PG8_BAR;
#undef PG8_SA
#undef PG8_SB
#undef PG8_STAGE
#undef PG8_LDA
#undef PG8_LDB
#undef PG8_MMA
#undef PG8_WAIT_V
#undef PG8_WAIT_L
#undef PG8_BAR
#undef PG8_SCHED
}
}

__device__ __forceinline__ void transpose_job(const float* W, int K, int N, int Npad, u16* dst, const float* gain, u16* tile) {
    const int tid = threadIdx.x, kt = K / 64, ntiles = (Npad / 64) * kt;
    for (int t0 = blockIdx.x; t0 < ntiles; t0 += 2 * gridDim.x) {
        __syncthreads();
        f32x4 v[2][2]; float gk[2][2];
#pragma unroll
        for (int tt = 0; tt < 2; ++tt) { const int t = t0 + tt * gridDim.x; const bool ok = t < ntiles; const int k0 = ok ? (t % kt) * 64 : 0, n0 = ok ? (t / kt) * 64 : 0;
#pragma unroll
            for (int i = 0; i < 2; ++i) { const int k = (tid >> 4) + 32 * i, n = n0 + (tid & 15) * 4;
                v[tt][i] = (f32x4){0.f, 0.f, 0.f, 0.f}; if (ok && n < N) v[tt][i] = *(const f32x4*)(W + (size_t)(k0 + k) * N + n);
                gk[tt][i] = gain ? gain[k0 + k] : 1.0f; } }
#pragma unroll
        for (int tt = 0; tt < 2; ++tt)
#pragma unroll
            for (int i = 0; i < 2; ++i) { const int k = (tid >> 4) + 32 * i, n4 = (tid & 15) * 4;
#pragma unroll
                for (int j = 0; j < 4; ++j) tile[tt * 64 * 72 + (n4 + j) * 72 + k] = f2bf(v[tt][i][j] * gk[tt][i]); }
        __syncthreads();
#pragma unroll
        for (int tt = 0; tt < 2; ++tt) { const int t = t0 + tt * gridDim.x;
            if (t < ntiles) { const int k0 = (t % kt) * 64, n0 = (t / kt) * 64; const int n = tid >> 3, k8 = (tid & 7) * 8;
                const u32x4 w = *(const u32x4*)(tile + tt * 64 * 72 + n * 72 + k8); *(u32x4*)(dst + (size_t)(n0 + n) * K + k0 + k8) = w; } }
    }
}
__device__ __forceinline__ void prep_phase(const Args& A, unsigned char* smem) {
    u16* tile = (u16*)smem; unsigned char* ws = A.ws;
    transpose_job(A.in[1], 1024, 5152, 5376, (u16*)(ws + WS_WIN0), A.in[18], tile);
    transpose_job(A.in[13], 2048, 1024, 1024, (u16*)(ws + WS_WOUT0), nullptr, tile);
    transpose_job(A.in[20], 1024, 4096, 4096, (u16*)(ws + WS_WUP0), A.in[19], tile);
    transpose_job(A.in[20] + (size_t)1024 * 4096, 1024, 4096, 4096, (u16*)(ws + WS_WUP1), A.in[19] + 1024, tile);
    transpose_job(A.in[21], 4096, 1024, 1024, (u16*)(ws + WS_WDN0), nullptr, tile);
    transpose_job(A.in[21] + (size_t)4096 * 1024, 4096, 1024, 1024, (u16*)(ws + WS_WDN1), nullptr, tile);
    transpose_job(A.in[14], 1024, 5120, 5120, (u16*)(ws + WS_WIN1), A.in[18] + 1024, tile);
    transpose_job(A.in[17], 1024, 1024, 1024, (u16*)(ws + WS_WOUT1), nullptr, tile);
    const int tid = threadIdx.x, lane = tid & 63, wave = tid >> 6;
    float* ss = (float*)(ws + WS_SS); u16* xb = (u16*)(ws + WS_XB); const float* x = A.in[0];
    const int stride = gridDim.x * 8;
    for (int row0 = blockIdx.x * 8 + wave; row0 < NTOK; row0 += 2 * stride) {
        f32x4 v[2][4]; float s2[2] = {0.f, 0.f};
#pragma unroll
        for (int rr = 0; rr < 2; ++rr) { const int row = (row0 + rr * stride < NTOK) ? row0 + rr * stride : row0;
#pragma unroll
            for (int i = 0; i < 4; ++i) v[rr][i] = *(const f32x4*)(x + (size_t)row * DM + lane * 4 + 256 * i); }
#pragma unroll
        for (int rr = 0; rr < 2; ++rr) { const int row = (row0 + rr * stride < NTOK) ? row0 + rr * stride : row0;
#pragma unroll
            for (int i = 0; i < 4; ++i) { const size_t o = (size_t)row * DM + lane * 4 + 256 * i; const f32x4 q = v[rr][i];
                s2[rr] += q[0] * q[0] + q[1] * q[1] + q[2] * q[2] + q[3] * q[3]; u32x2 w; w.x = pk2(q[0], q[1]); w.y = pk2(q[2], q[3]); *(u32x2*)(xb + o) = w; } }
#pragma unroll
        for (int d = 1; d < 64; d <<= 1) { s2[0] += __shfl_xor(s2[0], d); s2[1] += __shfl_xor(s2[1], d); }
        if (lane == 0) { ss[row0] = s2[0]; if (row0 + stride < NTOK) ss[row0 + stride] = s2[1]; }
    }
}

typedef short v4i16_t __attribute__((ext_vector_type(4)));
__device__ __forceinline__ v4i16_t lds_tr(const u16* p) { return __builtin_amdgcn_ds_read_tr16_b64_v4i16((LAS v4i16_t*)p); }
__device__ __forceinline__ bf16x8 tr_frag(const u16* base, int pitch, int k0, int x0, int lane) {
#if TR_GATHER
    const u16* a = base + (k0 + 8 * (lane >> 4)) * pitch + x0 + (lane & 15);
    bf16x8 r;
#pragma unroll
    for (int e = 0; e < 8; ++e) r[e] = (short)a[e * pitch];
    return r;
#else
    const int g = lane >> 4, q = (lane & 15) >> 2, p = lane & 3;
    const u16* a = base + (k0 + 8 * g + q) * pitch + x0 + 4 * p;
    const v4i16_t lo = lds_tr(a), hi = lds_tr(a + 4 * pitch);
    return (bf16x8){lo[0], lo[1], lo[2], lo[3], hi[0], hi[1], hi[2], hi[3]};
#endif
}
__device__ __forceinline__ void ssd_phase(const Args& A, unsigned char* smem, const bool dry) {
    u16* Cb = (u16*)smem;
    u16* Bb = Cb + 64 * 136;
    u16* Sb = Bb + 64 * 136;
    u16* Xb0 = Sb + 64 * 136;
    u16* XWb = Xb0 + 2 * 64 * 72;
    u16* Mb = XWb + 64 * 72;
    float* yb = (float*)(Mb + 64 * 72);
    float* cw = yb + 4096;
    float* cumv = cw; float* dtv = cumv + 64; float* wv = dtv + 64; float* ecv = wv + 64; float* etot = ecv + 64;
    const int tid = threadIdx.x, lane = tid & 63, wave = tid >> 6;
    u16* proj = (u16*)(A.ws + WS_PROJ); u16* tmp1 = (u16*)A.out; const float* dtraw = (const float*)(A.ws + WS_DT);
    const float* conv_w = A.in[2]; const float* conv_b = A.in[3];
    const int it = wave & 3, hh = wave >> 2, r16 = lane & 15, q4 = lane >> 4;
    for (int u = blockIdx.x; u < 256; u += gridDim.x) {
        const int b = u >> 4, h = u & 15, g = h >> 2;
        __syncthreads();
        const float Dh = A.in[6][h];
        for (int dir = 0; dir < 2; ++dir) {
            const float a_neg = -__expf(A.in[4][dir * 16 + h]); const float dtb = A.in[5][dir * 16 + h];
            f32x4 Sacc[4];
#pragma unroll
            for (int j = 0; j < 4; ++j) Sacc[j] = (f32x4){0.f, 0.f, 0.f, 0.f};
            __syncthreads();
            for (int e = tid; e < 64 * 136 / 2; e += 512) ((unsigned*)Sb)[e] = 0u;
            u32x4 pre[5]; float dpre = 0.f;
#define SSD_ISSUE(BT) do { \
    _Pragma("unroll") for (int k = 0; k < 5; ++k) { const int it_ = tid + 512 * k; const int o_ = it_ % 40, i_ = it_ / 40; \
        const int t_ = dir ? (SEQ - 1 - ((BT) * 64 + i_)) : ((BT) * 64 + i_); \
        const int col_ = o_ < 8 ? 64 * h + 8 * o_ : (o_ < 24 ? 1024 + 128 * g + 8 * (o_ - 8) : 1536 + 128 * g + 8 * (o_ - 24)); \
        pre[k] = *(const u32x4*)(proj + (size_t)(b * SEQ + t_) * PLD + col_); } \
    if (tid < 64) { const int t_ = dir ? (SEQ - 1 - ((BT) * 64 + tid)) : ((BT) * 64 + tid); dpre = dtraw[(size_t)(b * SEQ + t_) * 32 + dir * 16 + h]; } } while (0)
            SSD_ISSUE(0);
            for (int bt = 0; bt < 64; ++bt) {
                u16* Xb = Xb0 + (bt & 1) * (64 * 72);
#pragma unroll
                for (int k = 0; k < 5; ++k) { const int it_ = tid + 512 * k; const int o = it_ % 40, i = it_ / 40;
                    if (o < 8) *(u32x4*)(Xb + i * 72 + 8 * o) = pre[k];
                    else if (o < 24) *(u32x4*)(Bb + i * 136 + 8 * (o - 8)) = pre[k];
                    else *(u32x4*)(Cb + i * 136 + 8 * (o - 24)) = pre[k]; }
                if (tid < 64) {
                    const float v = dpre + dtb; const float dt = v > 20.f ? v : log1pf(__expf(v));
                    float c = dt * a_neg;
#pragma unroll
                    for (int d = 1; d < 64; d <<= 1) { const float tv = __shfl_up(c, d); if (lane >= d) c += tv; }
                    const float tot = __shfl(c, 63);
                    cumv[lane] = c; dtv[lane] = dt; wv[lane] = dt * __expf(tot - c); ecv[lane] = __expf(c); if (lane == 0) etot[0] = __expf(tot); }
                if (bt + 1 < 64) { SSD_ISSUE(bt + 1); }
                __syncthreads();
                { const int j = tid >> 3, p8 = (tid & 7) * 8; float f[8]; unpack8(*(const u32x4*)(Xb + j * 72 + p8), f); const float w = wv[j];
#pragma unroll
                    for (int e = 0; e < 8; ++e) f[e] *= w;
                    *(u32x4*)(XWb + j * 72 + p8) = pack8(f); }
                f32x4 yst[2];
                {
                    bf16x8 cf[4], bfr[2][4], sf[2][4];
#pragma unroll
                    for (int ks = 0; ks < 4; ++ks) cf[ks] = *(const bf16x8*)(Cb + (16 * it + r16) * 136 + 32 * ks + 8 * q4);
#pragma unroll
                    for (int jj = 0; jj < 2; ++jj)
#pragma unroll
                        for (int ks = 0; ks < 4; ++ks) bfr[jj][ks] = *(const bf16x8*)(Bb + (16 * (2 * hh + jj) + r16) * 136 + 32 * ks + 8 * q4);
#pragma unroll
                    for (int pp = 0; pp < 2; ++pp)
#pragma unroll
                        for (int ks = 0; ks < 4; ++ks) sf[pp][ks] = *(const bf16x8*)(Sb + (16 * (2 * hh + pp) + r16) * 136 + 32 * ks + 8 * q4);
                    const int i = 16 * it + r16; const float ci = cumv[i];
                    f32x4 cj[2], dj[2];
#pragma unroll
                    for (int jj = 0; jj < 2; ++jj) { cj[jj] = *(const f32x4*)(cumv + 16 * (2 * hh + jj) + 4 * q4); dj[jj] = *(const f32x4*)(dtv + 16 * (2 * hh + jj) + 4 * q4); }
                    __builtin_amdgcn_sched_barrier(0);
                    f32x4 gacc[2];
#pragma unroll
                    for (int jj = 0; jj < 2; ++jj) { gacc[jj] = (f32x4){0.f, 0.f, 0.f, 0.f};
#pragma unroll
                        for (int ks = 0; ks < 4; ++ks) gacc[jj] = __builtin_amdgcn_mfma_f32_16x16x32_bf16(bfr[jj][ks], cf[ks], gacc[jj], 0, 0, 0); }
#pragma unroll
                    for (int pp = 0; pp < 2; ++pp) { yst[pp] = (f32x4){0.f, 0.f, 0.f, 0.f};
#pragma unroll
                        for (int ks = 0; ks < 4; ++ks) yst[pp] = __builtin_amdgcn_mfma_f32_16x16x32_bf16(cf[ks], sf[pp][ks], yst[pp], 0, 0, 0); }
#pragma unroll
                    for (int jj = 0; jj < 2; ++jj) { const int jt = 2 * hh + jj; float m[4];
#pragma unroll
                        for (int r = 0; r < 4; ++r) { const int j = 16 * jt + 4 * q4 + r; m[r] = (j <= i) ? gacc[jj][r] * __expf(ci - cj[jj][r]) * dj[jj][r] : 0.f; }
                        u32x2 outw; outw.x = pk2(m[0], m[1]); outw.y = pk2(m[2], m[3]);
                        *(u32x2*)(Mb + (16 * it + r16) * 72 + 16 * jt + 4 * q4) = outw; }
                }
                __syncthreads();
                {
                    bf16x8 mf[2], xf[2][2], af[2], xwf[4][2];
#pragma unroll
                    for (int ks = 0; ks < 2; ++ks) mf[ks] = *(const bf16x8*)(Mb + (16 * it + r16) * 72 + 32 * ks + 8 * q4);
#pragma unroll
                    for (int pp = 0; pp < 2; ++pp)
#pragma unroll
                        for (int ks = 0; ks < 2; ++ks) xf[pp][ks] = tr_frag(Xb, 72, 32 * ks, 16 * (2 * hh + pp), lane);
#pragma unroll
                    for (int ks = 0; ks < 2; ++ks) af[ks] = tr_frag(Bb, 136, 32 * ks, 16 * wave, lane);
#pragma unroll
                    for (int pt = 0; pt < 4; ++pt)
#pragma unroll
                        for (int ks = 0; ks < 2; ++ks) xwf[pt][ks] = tr_frag(XWb, 72, 32 * ks, 16 * pt, lane);
                    const f32x4 ec = *(const f32x4*)(ecv + 16 * it + 4 * q4); const float et = etot[0];
                    __builtin_amdgcn_sched_barrier(0);
#pragma unroll
                    for (int pt = 0; pt < 4; ++pt) Sacc[pt] = Sacc[pt] * et;
                    f32x4 yin[2];
#pragma unroll
                    for (int pp = 0; pp < 2; ++pp) { yin[pp] = (f32x4){0.f, 0.f, 0.f, 0.f};
#pragma unroll
                        for (int ks = 0; ks < 2; ++ks) yin[pp] = __builtin_amdgcn_mfma_f32_16x16x32_bf16(mf[ks], xf[pp][ks], yin[pp], 0, 0, 0); }
#pragma unroll
                    for (int pt = 0; pt < 4; ++pt)
#pragma unroll
                        for (int ks = 0; ks < 2; ++ks) Sacc[pt] = __builtin_amdgcn_mfma_f32_16x16x32_bf16(af[ks], xwf[pt][ks], Sacc[pt], 0, 0, 0);
#pragma unroll
                    for (int pp = 0; pp < 2; ++pp) { const int pt = 2 * hh + pp;
#pragma unroll
                        for (int r = 0; r < 4; ++r) { const int i = 16 * it + 4 * q4 + r; yb[i * 64 + 16 * pt + r16] = yin[pp][r] + ec[r] * yst[pp][r]; } }
#pragma unroll
                    for (int pt = 0; pt < 4; ++pt) { u32x2 w; w.x = pk2(Sacc[pt][0], Sacc[pt][1]); w.y = pk2(Sacc[pt][2], Sacc[pt][3]);
                        *(u32x2*)(Sb + (16 * pt + r16) * 136 + 16 * wave + 4 * q4) = w; }
                }
                __syncthreads();
                { const int i = tid >> 3, p8 = (tid & 7) * 8; const int t = dir ? (SEQ - 1 - (bt * 64 + i)) : (bt * 64 + i); const size_t tok = (size_t)(b * SEQ + t);
                    float y[8];
#pragma unroll
                    for (int j = 0; j < 8; ++j) y[j] = yb[i * 64 + p8 + j];
                    if (dir == 0) {
                        { float xf[8]; unpack8(*(const u32x4*)(Xb + i * 72 + p8), xf);
#pragma unroll
                        for (int j = 0; j < 8; ++j) y[j] += Dh * xf[j]; }
                        if (!dry) *(u32x4*)(tmp1 + tok * 1024 + 64 * h + p8) = pack8(y);
                    } else {
                        float yf[8], z[8]; unpack8(*(const u32x4*)(tmp1 + tok * 1024 + 64 * h + p8), yf);
                        u16* zp = proj + tok * PLD + 3072 + 64 * h + p8; unpack8(*(const u32x4*)zp, z);
#pragma unroll
                        for (int j = 0; j < 8; ++j) y[j] = (y[j] + yf[j]) * siluf_(z[j]);
                        if (!dry) *(u32x4*)zp = pack8(y);
                    } }
            }
        }
    }
}

__device__ __forceinline__ void lru_phase(const Args& A, unsigned char* smem, const bool dry) {
    u16* wT = (u16*)smem;
    u16* ub = wT + 2 * 64 * 72;
    float* aL = (float*)(ub + 128 * 72);
    float* bL = aL + 128 * 64;
    float* segP = bL + 128 * 64; float* segH = segP + 512;
    float* hcar = segH + 512;
    const int tid = threadIdx.x, lane = tid & 63, wave = tid >> 6;
    u16* proj = (u16*)(A.ws + WS_PROJ); u16* tmp2 = (u16*)(A.ws + WS_TMP2);
    const int si = tid >> 3, c8 = (tid & 7) * 8, r16 = lane & 15, q4 = lane >> 4;
    for (int u = blockIdx.x; u < 256; u += gridDim.x) {
        const int b = u >> 4, nb = u & 15;
        for (int dir = 0; dir < 2; ++dir) {
            __syncthreads();
            for (int e = tid; e < 8192; e += 512) { const int gate = e >> 12, c = (e >> 6) & 63, d = e & 63;
                const float v = (gate ? A.in[10] : A.in[8])[(size_t)((dir * 16 + nb) * 64 + c) * 64 + d]; wT[(gate * 64 + d) * 72 + c] = f2bf(v); }
            if (tid < 64) hcar[tid] = 0.f;
            float ba[4], bx[4], sp[4];
#pragma unroll
            for (int dt = 0; dt < 4; ++dt) { const int ch = dir * 1024 + 64 * nb + 16 * dt + r16; ba[dt] = A.in[9][ch]; bx[dt] = A.in[11][ch];
                const float ml = -A.in[12][ch]; sp[dt] = ml > 20.f ? ml : log1pf(__expf(ml)); }
            u32x4 lpre[2];
#define LRU_ISSUE(BT) do { _Pragma("unroll") for (int k = 0; k < 2; ++k) { const int i_ = si + 64 * k; const int t_ = dir ? (SEQ - 1 - ((BT) * 128 + i_)) : ((BT) * 128 + i_); \
        lpre[k] = *(const u32x4*)(proj + (size_t)(b * SEQ + t_) * PLD + 2048 + 64 * nb + c8); } } while (0)
            LRU_ISSUE(0);
            for (int bt = 0; bt < 32; ++bt) {
                *(u32x4*)(ub + si * 72 + c8) = lpre[0]; *(u32x4*)(ub + (si + 64) * 72 + c8) = lpre[1];
                if (bt + 1 < 32) { LRU_ISSUE(bt + 1); }
                u32x4 hfp[2], ggp[2];
#pragma unroll
                for (int q = 0; q < 2; ++q) { hfp[q] = (u32x4){0u, 0u, 0u, 0u}; ggp[q] = hfp[q]; }
                if (dir) {
#pragma unroll
                    for (int q = 0; q < 2; ++q) { const int pp = lane + 64 * q; const int i = 16 * wave + (pp >> 3); const size_t tok = (size_t)(b * SEQ + (SEQ - 1 - (bt * 128 + i)));
                        hfp[q] = *(const u32x4*)(tmp2 + tok * 1024 + 64 * nb + 8 * (pp & 7)); ggp[q] = *(const u32x4*)(proj + tok * PLD + 4096 + 64 * nb + 8 * (pp & 7)); } }
                __syncthreads();
                { bf16x8 Af[2];
#pragma unroll
                    for (int ks = 0; ks < 2; ++ks) Af[ks] = *(const bf16x8*)(ub + (16 * wave + r16) * 72 + ks * 32 + q4 * 8);
#pragma unroll
                    for (int dt = 0; dt < 4; ++dt) { const int d = 16 * dt + r16;
                        f32x4 ga = (f32x4){0.f, 0.f, 0.f, 0.f}, gx = (f32x4){0.f, 0.f, 0.f, 0.f};
#pragma unroll
                        for (int ks = 0; ks < 2; ++ks) { const bf16x8 Ba = *(const bf16x8*)(wT + (d) * 72 + ks * 32 + q4 * 8); const bf16x8 Bx = *(const bf16x8*)(wT + (64 + d) * 72 + ks * 32 + q4 * 8);
                            ga = __builtin_amdgcn_mfma_f32_16x16x32_bf16(Af[ks], Ba, ga, 0, 0, 0); gx = __builtin_amdgcn_mfma_f32_16x16x32_bf16(Af[ks], Bx, gx, 0, 0, 0); }
#pragma unroll
                        for (int j = 0; j < 4; ++j) { const int i = 16 * wave + 4 * q4 + j;
                            const float ea = 1.0f + __expf(-(ga[j] + ba[dt])), ex = 1.0f + __expf(-(gx[j] + bx[dt])); const float rab = __builtin_amdgcn_rcpf(ea * ex);
                            const float rg = rab * ex, ig = rab * ea;
                            const float la = -8.0f * rg * sp[dt]; const float av = __expf(la); const float v2 = 2.0f * la;
                            const float em = (v2 > -0.02f) ? v2 * (1.0f + v2 * (0.5f + v2 * (1.0f / 6.0f))) : (av * av - 1.0f);
                            aL[i * 64 + d] = av; bL[i * 64 + d] = sqrtf(-em) * ig * bf2f(ub[i * 72 + d]); } } }
                __syncthreads();
                float Pr[16], Hr[16];
                { float P = 1.f, hl = 0.f;
#pragma unroll
                    for (int ii = 0; ii < 16; ++ii) { const int i = 16 * wave + ii; const float av = aL[i * 64 + lane], xv = bL[i * 64 + lane]; hl = av * hl + xv; P *= av; Pr[ii] = P; Hr[ii] = hl; }
                    segP[wave * 64 + lane] = P; segH[wave * 64 + lane] = hl; }
                __syncthreads();
                { float carry = hcar[(bt & 1) * 64 + lane];
                    for (int w2 = 0; w2 < wave; ++w2) carry = segP[w2 * 64 + lane] * carry + segH[w2 * 64 + lane];
                    u16* hfT = (u16*)(aL + 16 * wave * 64); u16* gT = hfT + 16 * 64;
                    if (dir) {
#pragma unroll
                        for (int q = 0; q < 2; ++q) { const int pp = lane + 64 * q; *(u32x4*)(hfT + (pp >> 3) * 64 + 8 * (pp & 7)) = hfp[q]; *(u32x4*)(gT + (pp >> 3) * 64 + 8 * (pp & 7)) = ggp[q]; } }
                    asm volatile("" ::: "memory");
#pragma unroll
                    for (int ii = 0; ii < 16; ++ii) { const float hv = Hr[ii] + Pr[ii] * carry;
                        float ov = hv;
                        if (dir) ov = (bf2f(hfT[ii * 64 + lane]) + hv) * gelu_tanh(bf2f(gT[ii * 64 + lane]));
                        hfT[ii * 64 + lane] = f2bf(ov); }
                    asm volatile("" ::: "memory");
#pragma unroll
                    for (int q = 0; q < 2; ++q) { const int pp = lane + 64 * q; const int i = 16 * wave + (pp >> 3);
                        const int t = dir ? (SEQ - 1 - (bt * 128 + i)) : (bt * 128 + i); const size_t tok = (size_t)(b * SEQ + t);
                        const u32x4 w = *(const u32x4*)(hfT + (pp >> 3) * 64 + 8 * (pp & 7));
                        if (!dry) { if (dir == 0) *(u32x4*)(tmp2 + tok * 1024 + 64 * nb + 8 * (pp & 7)) = w; else *(u32x4*)(proj + tok * PLD + 4096 + 64 * nb + 8 * (pp & 7)) = w; } }
                    if (wave == 7) hcar[((bt + 1) & 1) * 64 + lane] = segP[7 * 64 + lane] * carry + segH[7 * 64 + lane]; }
            }
#undef LRU_ISSUE
        }
    }
}

__device__ __forceinline__ void ssd_norm_phase(const Args& A) {
    const int tid = threadIdx.x, lane = tid & 63, wave = tid >> 6; u16* proj = (u16*)(A.ws + WS_PROJ);
    float nw[16];
#pragma unroll
    for (int j = 0; j < 16; ++j) nw[j] = A.in[7][16 * lane + j];
    const int stride = gridDim.x * 8;
    for (int row0 = blockIdx.x * 8 + wave; row0 < NTOK; row0 += 2 * stride) {
        u32x4 raw[2][2];
#pragma unroll
        for (int rr = 0; rr < 2; ++rr) { const u16* p = proj + (size_t)(row0 + rr * stride) * PLD + 3072 + 16 * lane; raw[rr][0] = *(const u32x4*)p; raw[rr][1] = *(const u32x4*)(p + 8); }
#pragma unroll
        for (int rr = 0; rr < 2; ++rr) { u16* p = proj + (size_t)(row0 + rr * stride) * PLD + 3072 + 16 * lane; float f[16]; unpack8(raw[rr][0], f); unpack8(raw[rr][1], f + 8);
            float s2 = 0.f;
#pragma unroll
            for (int j = 0; j < 16; ++j) s2 += f[j] * f[j];
            s2 += __shfl_xor(s2, 1); s2 += __shfl_xor(s2, 2); s2 += __shfl_xor(s2, 4); s2 += __shfl_xor(s2, 8);
            const float rs = rsqrtf(s2 * (1.0f / 256.0f) + EPS);
#pragma unroll
            for (int j = 0; j < 16; ++j) f[j] = f[j] * rs * nw[j];
            *(u32x4*)p = pack8(f); *(u32x4*)(p + 8) = pack8(f + 8); }
    }
}

__device__ __forceinline__ void hgrn_phase(const Args& A, unsigned char* smem, const bool dry) {
    u16* Qt = (u16*)smem;
    u16* Kt = Qt + 64 * 136;
    float* yb = (float*)smem;
    u16* Kw = Kt + 64 * 136;
    u16* Vb = Kw + 64 * 136;
    u16* Sb = Vb + 64 * 136;
    u16* Ab = Sb + 128 * 136;
    float* seg = (float*)(Ab + 64 * 72);
    float* decv = seg + 16 * 128;
    const int tid = threadIdx.x, lane = tid & 63, wave = tid >> 6;
    const int it = wave & 3, hh = wave >> 2, r16 = lane & 15, q4 = lane >> 4;
    const int cq = tid & 31, tg = tid >> 5, si = tid >> 3, c16 = (tid & 7) * 16;
    u16* proj = (u16*)(A.ws + WS_PROJ);
    for (int u = blockIdx.x; u < 256; u += gridDim.x) {
        const int b = u >> 4, dir = (u >> 3) & 1, h = u & 7;
        float lbk[4];
#pragma unroll
        for (int c = 0; c < 4; ++c) lbk[c] = sigmoidf_(A.in[15][1024 + 128 * h + 4 * cq + c] - A.in[15][128 * h + 4 * cq + c]);
        f32x4 Sacc[8];
#pragma unroll
        for (int j = 0; j < 8; ++j) Sacc[j] = (f32x4){0.f, 0.f, 0.f, 0.f};
        __syncthreads();
        for (int e = tid; e < 128 * 136 / 2; e += 512) ((unsigned*)Sb)[e] = 0u;
        u32x2 frp[4], qrp[4]; u32x4 vp0, vp1;
#define HG_ISSUE(BT) do { \
    _Pragma("unroll") for (int e = 0; e < 4; ++e) { const int i_ = 4 * tg + e; const int t_ = dir ? (SEQ - 1 - ((BT) * 64 + i_)) : ((BT) * 64 + i_); const u16* row_ = proj + (size_t)(b * SEQ + t_) * PLD + 128 * h + 4 * cq; \
        frp[e] = *(const u32x2*)(row_ + 1024 + dir * 1024); qrp[e] = *(const u32x2*)(row_); } \
    { const int t_ = dir ? (SEQ - 1 - ((BT) * 64 + si)) : ((BT) * 64 + si); const u16* row_ = proj + (size_t)(b * SEQ + t_) * PLD + 3072 + 128 * h + c16; vp0 = *(const u32x4*)row_; vp1 = *(const u32x4*)(row_ + 8); } } while (0)
        HG_ISSUE(0);
        for (int bt = 0; bt < 64; ++bt) {
            float Pl[4][4], kk[4][4];
            { float P[4] = {1.0f, 1.0f, 1.0f, 1.0f};
#pragma unroll
                for (int e = 0; e < 4; ++e) { const float fr[4] = {bf_lo(frp[e].x), bf_hi(frp[e].x), bf_lo(frp[e].y), bf_hi(frp[e].y)};
#pragma unroll
                    for (int c = 0; c < 4; ++c) { const float f = lbk[c] + (1.0f - lbk[c]) * sigmoidf_(fr[c]); P[c] *= f; Pl[e][c] = P[c]; kk[e][c] = 1.0f - f; } }
                *(f32x4*)(seg + tg * 128 + 4 * cq) = (f32x4){P[0], P[1], P[2], P[3]}; }
            { *(u32x4*)(Vb + si * 136 + c16) = vp0; *(u32x4*)(Vb + si * 136 + c16 + 8) = vp1; }
            __syncthreads();
            { f32x4 pre = (f32x4){1.f, 1.f, 1.f, 1.f}, tot = pre;
#pragma unroll
                for (int g2 = 0; g2 < 16; ++g2) { const f32x4 sv = *(const f32x4*)(seg + g2 * 128 + 4 * cq); tot = tot * sv; const f32x4 pv = pre * sv; pre = (g2 < tg) ? pv : pre; }
#pragma unroll
                for (int e = 0; e < 4; ++e) { const int i = 4 * tg + e; const float qv[4] = {bf_lo(qrp[e].x), bf_hi(qrp[e].x), bf_lo(qrp[e].y), bf_hi(qrp[e].y)};
                    float oq[4], ok[4], ow[4];
#pragma unroll
                    for (int c = 0; c < 4; ++c) { const float Pc = Pl[e][c] * pre[c]; const float rP = __builtin_amdgcn_rcpf(Pc);
                        oq[c] = qv[c] * 0.08838834764831845f * Pc; ok[c] = kk[e][c] * rP; ow[c] = kk[e][c] * tot[c] * rP; }
                    u32x2 w; w.x = pk2(oq[0], oq[1]); w.y = pk2(oq[2], oq[3]); *(u32x2*)(Qt + i * 136 + 4 * cq) = w;
                    w.x = pk2(ok[0], ok[1]); w.y = pk2(ok[2], ok[3]); *(u32x2*)(Kt + i * 136 + 4 * cq) = w;
                    w.x = pk2(ow[0], ow[1]); w.y = pk2(ow[2], ow[3]); *(u32x2*)(Kw + i * 136 + 4 * cq) = w; }
                if (tg == 0) *(f32x4*)(decv + 4 * cq) = tot; }
            if (bt + 1 < 64) { HG_ISSUE(bt + 1); }
            __syncthreads();
            f32x4 yst[4];
            {
                bf16x8 aq[4], kf[2][4];
#pragma unroll
                for (int ks = 0; ks < 4; ++ks) aq[ks] = *(const bf16x8*)(Qt + (16 * it + r16) * 136 + 32 * ks + 8 * q4);
#pragma unroll
                for (int jj = 0; jj < 2; ++jj)
#pragma unroll
                    for (int ks = 0; ks < 4; ++ks) kf[jj][ks] = *(const bf16x8*)(Kt + (16 * (2 * hh + jj) + r16) * 136 + 32 * ks + 8 * q4);
                __builtin_amdgcn_sched_barrier(0);
                f32x4 gacc[2];
#pragma unroll
                for (int jj = 0; jj < 2; ++jj) { gacc[jj] = (f32x4){0.f, 0.f, 0.f, 0.f};
#pragma unroll
                    for (int ks = 0; ks < 4; ++ks) gacc[jj] = __builtin_amdgcn_mfma_f32_16x16x32_bf16(kf[jj][ks], aq[ks], gacc[jj], 0, 0, 0); }
#pragma unroll
                for (int half = 0; half < 2; ++half) {
                    bf16x8 sf[2][4];
#pragma unroll
                    for (int v2 = 0; v2 < 2; ++v2)
#pragma unroll
                        for (int ks = 0; ks < 4; ++ks) sf[v2][ks] = *(const bf16x8*)(Sb + (16 * (4 * hh + 2 * half + v2) + r16) * 136 + 32 * ks + 8 * q4);
                    __builtin_amdgcn_sched_barrier(0);
#pragma unroll
                    for (int v2 = 0; v2 < 2; ++v2) { f32x4 acc = (f32x4){0.f, 0.f, 0.f, 0.f};
#pragma unroll
                        for (int ks = 0; ks < 4; ++ks) acc = __builtin_amdgcn_mfma_f32_16x16x32_bf16(aq[ks], sf[v2][ks], acc, 0, 0, 0);
                        yst[2 * half + v2] = acc; } }
                const int i = 16 * it + r16;
#pragma unroll
                for (int jj = 0; jj < 2; ++jj) { const int jt = 2 * hh + jj; float m[4];
#pragma unroll
                    for (int r = 0; r < 4; ++r) { const int j = 16 * jt + 4 * q4 + r; m[r] = (j <= i) ? gacc[jj][r] : 0.f; }
                    u32x2 outw; outw.x = pk2(m[0], m[1]); outw.y = pk2(m[2], m[3]);
                    *(u32x2*)(Ab + (16 * it + r16) * 72 + 16 * jt + 4 * q4) = outw; }
            }
            __syncthreads();
            {
                bf16x8 aa[2], af[2], vf[8][2];
#pragma unroll
                for (int ks = 0; ks < 2; ++ks) { aa[ks] = *(const bf16x8*)(Ab + (16 * it + r16) * 72 + 32 * ks + 8 * q4); af[ks] = tr_frag(Kw, 136, 32 * ks, 16 * wave, lane); }
#pragma unroll
                for (int vt = 0; vt < 8; ++vt)
#pragma unroll
                    for (int ks = 0; ks < 2; ++ks) vf[vt][ks] = tr_frag(Vb, 136, 32 * ks, 16 * vt, lane);
                const f32x4 dec = *(const f32x4*)(decv + 16 * wave + 4 * q4);
                __builtin_amdgcn_sched_barrier(0);
#pragma unroll
                for (int vv = 0; vv < 4; ++vv) { const int vt = 4 * hh + vv; f32x4 acc = yst[vv];
#pragma unroll
                    for (int ks = 0; ks < 2; ++ks) acc = __builtin_amdgcn_mfma_f32_16x16x32_bf16(aa[ks], (hh ? vf[4 + vv][ks] : vf[vv][ks]), acc, 0, 0, 0);
#pragma unroll
                    for (int r = 0; r < 4; ++r) yb[(16 * it + 4 * q4 + r) * 128 + 16 * vt + r16] = acc[r]; }
#pragma unroll
                for (int vt = 0; vt < 8; ++vt) { Sacc[vt] = Sacc[vt] * dec;
#pragma unroll
                    for (int ks = 0; ks < 2; ++ks) Sacc[vt] = __builtin_amdgcn_mfma_f32_16x16x32_bf16(af[ks], vf[vt][ks], Sacc[vt], 0, 0, 0);
                    u32x2 w; w.x = pk2(Sacc[vt][0], Sacc[vt][1]); w.y = pk2(Sacc[vt][2], Sacc[vt][3]);
                    *(u32x2*)(Sb + (16 * vt + r16) * 136 + 16 * wave + 4 * q4) = w; }
            }
            __syncthreads();
            { const int t = dir ? (SEQ - 1 - (bt * 64 + si)) : (bt * 64 + si); u16* dst = proj + (size_t)(b * SEQ + t) * PLD + 1024 + dir * 1024 + 128 * h + c16;
                float f[16];
#pragma unroll
                for (int j = 0; j < 16; ++j) f[j] = yb[si * 128 + c16 + j];
                if (!dry) { *(u32x4*)dst = pack8(f); *(u32x4*)(dst + 8) = pack8(f + 8); } }
        }
    }
}
__device__ __forceinline__ void hgrn_norm_phase(const Args& A) {
    const int tid = threadIdx.x, lane = tid & 63, wave = tid >> 6; u16* proj = (u16*)(A.ws + WS_PROJ);
    float nw[16];
#pragma unroll
    for (int j = 0; j < 16; ++j) nw[j] = A.in[16][16 * lane + j];
    const int stride = gridDim.x * 8;
    for (int row0 = blockIdx.x * 8 + wave; row0 < NTOK; row0 += 2 * stride) {
        u32x4 raw[2][6];
#pragma unroll
        for (int rr = 0; rr < 2; ++rr) { const u16* p = proj + (size_t)(row0 + rr * stride) * PLD + 16 * lane;
            raw[rr][0] = *(const u32x4*)(p + 1024); raw[rr][1] = *(const u32x4*)(p + 1032); raw[rr][2] = *(const u32x4*)(p + 2048); raw[rr][3] = *(const u32x4*)(p + 2056);
            raw[rr][4] = *(const u32x4*)(p + 4096); raw[rr][5] = *(const u32x4*)(p + 4104); }
#pragma unroll
        for (int rr = 0; rr < 2; ++rr) { u16* p = proj + (size_t)(row0 + rr * stride) * PLD + 16 * lane; float f[16], g[16];
            unpack8(raw[rr][0], f); unpack8(raw[rr][1], f + 8); unpack8(raw[rr][2], g); unpack8(raw[rr][3], g + 8);
            float s2 = 0.f;
#pragma unroll
            for (int j = 0; j < 16; ++j) { f[j] += g[j]; s2 += f[j] * f[j]; }
            s2 += __shfl_xor(s2, 1); s2 += __shfl_xor(s2, 2); s2 += __shfl_xor(s2, 4);
            const float rs = rsqrtf(s2 * (1.0f / 128.0f) + EPS);
            unpack8(raw[rr][4], g); unpack8(raw[rr][5], g + 8);
#pragma unroll
            for (int j = 0; j < 16; ++j) f[j] = f[j] * rs * nw[j] * siluf_(g[j]);
            *(u32x4*)p = pack8(f); *(u32x4*)(p + 8) = pack8(f + 8); }
    }
}
__device__ __forceinline__ void final_norm_phase(const Args& A) {
    const u16* xb = (const u16*)(A.ws + WS_XB); const float* ss4 = (const float*)(A.ws + WS_SSP) + (size_t)3 * NTOK * 16; float* out = A.out; const float* nf = A.in[22];
    const int c8 = (threadIdx.x & 127) * 8;
    const f32x4 g0 = *(const f32x4*)(nf + c8), g1 = *(const f32x4*)(nf + c8 + 4);
    for (int row = blockIdx.x * 4 + (threadIdx.x >> 7); row < NTOK; row += gridDim.x * 8) {
        const u32x4 r0 = *(const u32x4*)(xb + (size_t)row * DM + c8); const int row2 = (row + (int)gridDim.x * 4 < NTOK) ? row + (int)gridDim.x * 4 : row; const u32x4 r1 = *(const u32x4*)(xb + (size_t)row2 * DM + c8);
        float s0, s1;
        { const f32x4 p0 = *(const f32x4*)(ss4 + (size_t)row * 16), p1 = *(const f32x4*)(ss4 + (size_t)row * 16 + 4), p2 = *(const f32x4*)(ss4 + (size_t)row * 16 + 8), p3 = *(const f32x4*)(ss4 + (size_t)row * 16 + 12);
            s0 = ((((p0[0] + p0[1]) + (p0[2] + p0[3])) + ((p1[0] + p1[1]) + (p1[2] + p1[3]))) + (((p2[0] + p2[1]) + (p2[2] + p2[3])) + ((p3[0] + p3[1]) + (p3[2] + p3[3])))); }
        { const f32x4 p0 = *(const f32x4*)(ss4 + (size_t)row2 * 16), p1 = *(const f32x4*)(ss4 + (size_t)row2 * 16 + 4), p2 = *(const f32x4*)(ss4 + (size_t)row2 * 16 + 8), p3 = *(const f32x4*)(ss4 + (size_t)row2 * 16 + 12);
            s1 = ((((p0[0] + p0[1]) + (p0[2] + p0[3])) + ((p1[0] + p1[1]) + (p1[2] + p1[3]))) + (((p2[0] + p2[1]) + (p2[2] + p2[3])) + ((p3[0] + p3[1]) + (p3[2] + p3[3])))); }
        float f[8]; unpack8(r0, f); float rs = rsqrtf(s0 * (1.0f / 1024.0f) + EPS);
        *(f32x4*)(out + (size_t)row * DM + c8) = (f32x4){f[0], f[1], f[2], f[3]} * rs * g0; *(f32x4*)(out + (size_t)row * DM + c8 + 4) = (f32x4){f[4], f[5], f[6], f[7]} * rs * g1;
        unpack8(r1, f); rs = rsqrtf(s1 * (1.0f / 1024.0f) + EPS);
        *(f32x4*)(out + (size_t)row2 * DM + c8) = (f32x4){f[0], f[1], f[2], f[3]} * rs * g0; *(f32x4*)(out + (size_t)row2 * DM + c8 + 4) = (f32x4){f[4], f[5], f[6], f[7]} * rs * g1;
    }
}

#define XB_TMO      128
#define XB_XCNT(j)  (256  + 64 * (j))
#define XB_XSUB(j)  (1280 + 64 * (j))
#define XB_XGEN(j)  (2304 + 64 * (j))
#define XB_TOP      3328
#define XB_TOPGEN   3392
#define XCD_BAR_WORDS 3456
#define XB_SPIN_CAP (1u << 18)
__device__ __forceinline__ unsigned xb_ld(unsigned* p)              { return __hip_atomic_load(p, __ATOMIC_RELAXED, __HIP_MEMORY_SCOPE_AGENT); }
__device__ __forceinline__ unsigned xb_add(unsigned* p, unsigned v) { return __hip_atomic_fetch_add(p, v, __ATOMIC_RELAXED, __HIP_MEMORY_SCOPE_AGENT); }
__device__ __forceinline__ unsigned xb_xcc_id() { return (unsigned)__builtin_amdgcn_s_getreg((3 << 11) | 20) & 0xFu; }
#define XB_SPIN(cond, bar) do { unsigned _sp = 0; while (cond) { __builtin_amdgcn_s_sleep(1); \
    if ((++_sp & 255u) == 0u) { if (xb_ld(&(bar)[XB_TMO])) break; if (_sp > XB_SPIN_CAP) { atomicAdd(&(bar)[XB_TMO], 1u); break; } } } } while (0)
struct XcdBarrier { unsigned* bar; unsigned x; volatile LAS unsigned* st; };
__device__ __forceinline__ XcdBarrier xcd_barrier_post(unsigned* bar, volatile LAS unsigned* st) {
    XcdBarrier b; b.bar = bar; b.x = xb_xcc_id(); b.st = st;
    if (threadIdx.x == 0) (void)xb_add(&bar[XB_XCNT(b.x)], 1u);
    return b;
}
__device__ __forceinline__ void xcd_barrier_complete(unsigned* bar, unsigned x, unsigned& nloc, unsigned& nx) {
    const unsigned G = gridDim.x * gridDim.y * gridDim.z;
    unsigned sum, cnt, mine, sp = 0u;
    for (;;) {
        sum = 0u; cnt = 0u; mine = 0u;
#pragma unroll
        for (unsigned j = 0; j < 16; ++j) { const unsigned c = xb_ld(&bar[XB_XCNT(j)]); sum += c; cnt += (c > 0u) ? 1u : 0u; mine = (j == x) ? c : mine; }
        if (sum == G) break;
        __builtin_amdgcn_s_sleep(1);
        if ((++sp & 255u) == 0u) { if (xb_ld(&bar[XB_TMO])) break; if (sp > XB_SPIN_CAP) { atomicAdd(&bar[XB_TMO], 1u); break; } }
    }
    nloc = mine > 0u ? mine : 1u; nx = cnt > 0u ? cnt : 1u;
}
__device__ __forceinline__ void xcd_barrier(const XcdBarrier& b) {
    asm volatile("s_waitcnt vmcnt(0)" ::: "memory");
    __syncthreads();
    if (threadIdx.x == 0) {
        unsigned* bar = b.bar;
        __builtin_amdgcn_s_waitcnt(0);
        unsigned nloc = b.st[0], nx = b.st[1];
        if (nloc == 0u) { xcd_barrier_complete(bar, b.x, nloc, nx); b.st[0] = nloc; b.st[1] = nx; }
        const unsigned old = xb_add(&bar[XB_XSUB(b.x)], 1u);
        const unsigned gen = old / nloc;
        if (old + 1u == (gen + 1u) * nloc) {
            __builtin_amdgcn_fence(__ATOMIC_RELEASE, "agent");
            asm volatile("s_waitcnt vmcnt(0)" ::: "memory");
            const unsigned og = xb_add(&bar[XB_TOP], 1u);
            const unsigned tg = og / nx;
            if (og + 1u == (tg + 1u) * nx) xb_add(&bar[XB_TOPGEN], 1u);
            else XB_SPIN(xb_ld(&bar[XB_TOPGEN]) == tg, bar);
            __builtin_amdgcn_fence(__ATOMIC_ACQUIRE, "agent");
            xb_add(&bar[XB_XGEN(b.x)], 1u);
            asm volatile("s_waitcnt vmcnt(0)" ::: "memory");
        } else {
            XB_SPIN(xb_ld(&bar[XB_XGEN(b.x)]) == gen, bar);
            __builtin_amdgcn_fence(__ATOMIC_ACQUIRE, "agent");
            asm volatile("s_waitcnt vmcnt(0)" ::: "memory");
        }
    }
    __syncthreads();
}

__device__ __forceinline__ void conv_halo(const u16* proj, u32x4* hbuf, int id) {
    if (id < 16 * 64 * 384) { const int oc = id % 384, sg = (id / 384) & 63, b = id / (384 * 64); const int t0 = sg * 64;
        const u16* base = proj + (size_t)(b * SEQ) * PLD + 8 * oc; u32x4 h0 = (u32x4){0u, 0u, 0u, 0u}, h1 = h0, h2 = h0;
        if (t0 > 0) h0 = *(const u32x4*)(base + (size_t)(t0 - 1) * PLD);
        if (t0 + 64 < SEQ) { h1 = *(const u32x4*)(base + (size_t)(t0 + 64) * PLD); h2 = *(const u32x4*)(base + (size_t)(t0 + 65) * PLD); }
        hbuf[(size_t)id * 3] = h0; hbuf[(size_t)id * 3 + 1] = h1; hbuf[(size_t)id * 3 + 2] = h2; }
}
template <bool ACT> __device__ __forceinline__ void conv_batch(u16* base, int eb, const u32x4 (&rw)[8], float (&win)[4][8], const float (&wk)[4][8], const float (&bs)[8]) {
#pragma unroll
    for (int j = 0; j < 8; ++j) { unpack8(rw[j], win[(j + 3) & 3]);
        float acc[8];
#pragma unroll
        for (int c = 0; c < 8; ++c) { float a = bs[c];
#pragma unroll
            for (int kk = 0; kk < 4; ++kk) a += wk[kk][c] * win[(j + kk) & 3][c];
            acc[c] = ACT ? siluf_(a) : a; }
        *(u32x4*)(base + (size_t)(eb + j) * PLD) = pack8(acc); }
}
template <bool ACT> __device__ __forceinline__ void conv_sweep_t(u16* base, const float* conv_w, const float* conv_b, int oc, const u32x4 h0, const u32x4 h1, const u32x4 h2) {
    float wk[4][8], bs[8];
#pragma unroll
    for (int kk = 0; kk < 4; ++kk) { const f32x4 a0 = *(const f32x4*)(conv_w + kk * 3072 + 8 * oc), a1 = *(const f32x4*)(conv_w + kk * 3072 + 8 * oc + 4);
        wk[kk][0] = a0[0]; wk[kk][1] = a0[1]; wk[kk][2] = a0[2]; wk[kk][3] = a0[3]; wk[kk][4] = a1[0]; wk[kk][5] = a1[1]; wk[kk][6] = a1[2]; wk[kk][7] = a1[3]; }
    { const f32x4 a0 = *(const f32x4*)(conv_b + 8 * oc), a1 = *(const f32x4*)(conv_b + 8 * oc + 4);
        bs[0] = a0[0]; bs[1] = a0[1]; bs[2] = a0[2]; bs[3] = a0[3]; bs[4] = a1[0]; bs[5] = a1[1]; bs[6] = a1[2]; bs[7] = a1[3]; }
    float win[4][8];
    unpack8(h0, win[0]); unpack8(*(const u32x4*)(base), win[1]); unpack8(*(const u32x4*)(base + PLD), win[2]);
    u32x4 ra[8], rb[8];
#pragma unroll
    for (int j = 0; j < 8; ++j) ra[j] = *(const u32x4*)(base + (size_t)(2 + j) * PLD);
#pragma unroll 1
    for (int eb = 0; eb < 48; eb += 16) {
#pragma unroll
        for (int j = 0; j < 8; ++j) rb[j] = *(const u32x4*)(base + (size_t)(eb + 10 + j) * PLD);
        conv_batch<ACT>(base, eb, ra, win, wk, bs);
#pragma unroll
        for (int j = 0; j < 8; ++j) ra[j] = *(const u32x4*)(base + (size_t)(eb + 18 + j) * PLD);
        conv_batch<ACT>(base, eb + 8, rb, win, wk, bs);
    }
#pragma unroll
    for (int j = 0; j < 6; ++j) rb[j] = *(const u32x4*)(base + (size_t)(58 + j) * PLD);
    rb[6] = h1; rb[7] = h2;
    conv_batch<ACT>(base, 48, ra, win, wk, bs);
    conv_batch<ACT>(base, 56, rb, win, wk, bs);
}
__device__ __forceinline__ void conv_sweep(u16* proj, const float* conv_w, const float* conv_b, const u32x4* hbuf, int id) {
    if (id >= 16 * 64 * 384) return;
    const u32x4 h0 = hbuf[(size_t)id * 3], h1 = hbuf[(size_t)id * 3 + 1], h2 = hbuf[(size_t)id * 3 + 2];
    const int oc = id % 384, sg = (id / 384) & 63, b = id / (384 * 64); const int t0 = sg * 64;
    u16* base = proj + (size_t)(b * SEQ + t0) * PLD + 8 * oc;
    if (oc < 256) conv_sweep_t<true>(base, conv_w, conv_b, oc, h0, h1, h2);
    else conv_sweep_t<false>(base, conv_w, conv_b, oc, h0, h1, h2);
}
__device__ __forceinline__ void conv_phase(const Args& A, const XcdBarrier& xbar) {
    u16* proj = (u16*)(A.ws + WS_PROJ); const float* conv_w = A.in[2]; const float* conv_b = A.in[3];
    const int nthr = gridDim.x * 512, gt = blockIdx.x * 512 + threadIdx.x;
    u32x4* hbuf = (u32x4*)(A.ws + WS_HALO);
    conv_halo(proj, hbuf, gt); conv_halo(proj, hbuf, gt + nthr); conv_halo(proj, hbuf, gt + 2 * nthr);
    xcd_barrier(xbar);
    conv_sweep(proj, conv_w, conv_b, hbuf, gt);
    asm volatile("" ::: "memory");
    conv_sweep(proj, conv_w, conv_b, hbuf, gt + nthr);
    asm volatile("" ::: "memory");
    conv_sweep(proj, conv_w, conv_b, hbuf, gt + 2 * nthr);
}

constexpr int NPHASE = 15;
template <bool COOP>
__global__ void __launch_bounds__(512, 2) mega(Args A) {
    extern __shared__ __attribute__((aligned(16))) unsigned char smem[];
    LAS unsigned char* lds = (LAS unsigned char*)smem;
    unsigned char* ws = A.ws; const int G = gridDim.x, c = blockIdx.x;
    float* ss = (float*)(ws + WS_SS); float* ssp = (float*)(ws + WS_SSP); u16* xb = (u16*)(ws + WS_XB); u16* proj = (u16*)(ws + WS_PROJ); float* dt = (float*)(ws + WS_DT);
#define IN(k) (A.lo <= (k) && (k) < A.hi)
    XcdBarrier xbar; xbar.bar = (unsigned*)(ws + WS_BAR); xbar.x = 0; xbar.st = (volatile LAS unsigned*)(lds + 131072);
    if (COOP) { if (threadIdx.x < 4) ((LAS unsigned*)(lds + 131072))[threadIdx.x] = 0u;
        if (blockIdx.x == 0 && threadIdx.x < 51) { const int i_ = threadIdx.x;
            const int w_ = i_ < 16 ? XB_XCNT(i_) : (i_ < 32 ? XB_XSUB(i_ - 16) : (i_ < 48 ? XB_XGEN(i_ - 32) : (i_ == 48 ? XB_TOP : (i_ == 49 ? XB_TOPGEN : XB_TMO))));
            __hip_atomic_store((unsigned*)(ws + WS_BAR) + w_, 0u, __ATOMIC_RELAXED, __HIP_MEMORY_SCOPE_AGENT); }
        __syncthreads(); }
#define SEAM(k) do { if (COOP && IN(k) && IN((k) + 1)) { if ((k) == 0) { cg::this_grid().sync(); xbar = xcd_barrier_post((unsigned*)(ws + WS_BAR), (volatile LAS unsigned*)(lds + 131072)); } else xcd_barrier(xbar); } } while (0)
    if (IN(0)) prep_phase(A, smem);
    SEAM(0);
    if (IN(1)) { pg8::Gemm g{xb, (const u16*)(ws + WS_WIN0), NTOK, 5376, 1024, 1024}; pg8::StaticOrder S; S.init(NTOK, 5376, G, c);
        pg8::EpiScale<0, true, 1> E{proj, PLD, ss, dt}; pg8::gemm_phase(lds, g, S, E); }
    SEAM(1);
    if (IN(2)) conv_phase(A, xbar);
    SEAM(2);
    if (IN(3)) { ssd_phase(A, smem, false); lru_phase(A, smem, false); }
    SEAM(3);
    if (IN(4)) ssd_norm_phase(A);
    SEAM(4);
    if (IN(5)) { pg8::Gemm g{proj + 3072, (const u16*)(ws + WS_WOUT0), NTOK, 1024, 2048, PLD}; pg8::StaticOrder S; S.init(NTOK, 1024, G, c);
        pg8::EpiResid<false> E{xb, A.out, ssp}; pg8::gemm_phase(lds, g, S, E); }
    SEAM(5);
    if (IN(6)) { pg8::Gemm g{xb, (const u16*)(ws + WS_WUP0), NTOK, 4096, 1024, 1024}; pg8::StaticOrder S; S.init(NTOK, 4096, G, c);
        pg8::EpiScale<1, false, 16> E{proj, 4096, ssp, nullptr}; pg8::gemm_phase(lds, g, S, E); }
    SEAM(6);
    if (IN(7)) { pg8::Gemm g{proj, (const u16*)(ws + WS_WDN0), NTOK, 1024, 4096, 4096}; pg8::StaticOrder S; S.init(NTOK, 1024, G, c);
        pg8::EpiResid<false> E{xb, A.out, ssp + (size_t)NTOK * 16}; pg8::gemm_phase(lds, g, S, E); }
    SEAM(7);
    if (IN(8)) { pg8::Gemm g{xb, (const u16*)(ws + WS_WIN1), NTOK, 5120, 1024, 1024}; pg8::StaticOrder S; S.init(NTOK, 5120, G, c);
        pg8::EpiScale<0, false, 16> E{proj, PLD, ssp + (size_t)NTOK * 16, nullptr}; pg8::gemm_phase(lds, g, S, E); }
    SEAM(8);
    if (IN(9)) { hgrn_phase(A, smem, false); }
    SEAM(9);
    if (IN(10)) hgrn_norm_phase(A);
    SEAM(10);
    if (IN(11)) { pg8::Gemm g{proj, (const u16*)(ws + WS_WOUT1), NTOK, 1024, 1024, PLD}; pg8::StaticOrder S; S.init(NTOK, 1024, G, c);
        pg8::EpiResid<false> E{xb, A.out, ssp + (size_t)2 * NTOK * 16}; pg8::gemm_phase(lds, g, S, E); }
    SEAM(11);
    if (IN(12)) { pg8::Gemm g{xb, (const u16*)(ws + WS_WUP1), NTOK, 4096, 1024, 1024}; pg8::StaticOrder S; S.init(NTOK, 4096, G, c);
        pg8::EpiScale<1, false, 16> E{proj, 4096, ssp + (size_t)2 * NTOK * 16, nullptr}; pg8::gemm_phase(lds, g, S, E); }
    SEAM(12);
    if (IN(13)) { pg8::Gemm g{proj, (const u16*)(ws + WS_WDN1), NTOK, 1024, 4096, 4096}; pg8::StaticOrder S; S.init(NTOK, 1024, G, c);
        pg8::EpiResid<false> E{xb, A.out, ssp + (size_t)3 * NTOK * 16}; pg8::gemm_phase(lds, g, S, E); }
    SEAM(13);
    if (IN(14)) final_norm_phase(A);
#undef IN
#undef SEAM
}

#ifndef PROBE_MASK
#define PROBE_MASK 0
#endif
#ifndef N_LAUNCH_MODE
#define N_LAUNCH_MODE 1
#endif

extern "C" void kernel_launch(void* const* d_in, const int* in_sizes, int n_in, void* d_out, int out_size, void* d_ws, size_t ws_size, hipStream_t stream) {
    static int grid = 0;
    if (grid == 0) {
        if (n_in != 23 || out_size != NTOK * DM || ws_size < WS_END) { fprintf(stderr, "kernel_launch: unexpected shapes (n_in %d out %d ws %zu need %zu)\n", n_in, out_size, ws_size, (size_t)WS_END); grid = -1; return; }
        int dev = 0, cus = 0, per_cu = 0;
        (void)hipGetDevice(&dev); (void)hipDeviceGetAttribute(&cus, hipDeviceAttributeMultiprocessorCount, dev);
        (void)hipFuncSetAttribute((const void*)mega<true>, hipFuncAttributeMaxDynamicSharedMemorySize, LDS_BYTES);
#if N_LAUNCH_MODE != 1
        (void)hipFuncSetAttribute((const void*)mega<false>, hipFuncAttributeMaxDynamicSharedMemorySize, LDS_BYTES);
#endif
        (void)hipOccupancyMaxActiveBlocksPerMultiprocessor(&per_cu, (const void*)mega<true>, 512, LDS_BYTES);
        if (per_cu < 1) per_cu = 1;
        (void)hipGetLastError();
        grid = cus * per_cu;
        if (grid <= 0) grid = 256;
    }
    if (grid < 0) return;
    Args a{};
    for (int i = 0; i < 23; ++i) a.in[i] = (const float*)d_in[i];
    a.out = (float*)d_out; a.ws = (unsigned char*)d_ws; a.probe = PROBE_MASK;
#if N_LAUNCH_MODE == 1
    a.lo = 0; a.hi = NPHASE;
    void* args[] = {&a};
    hipError_t e = hipLaunchCooperativeKernel((const void*)mega<true>, dim3(grid), dim3(512), args, LDS_BYTES, stream);
    if (e != hipSuccess) fprintf(stderr, "cooperative launch failed: %s (grid %d)\n", hipGetErrorString(e), grid);
#else
    for (int k = 0; k < NPHASE; ++k) { a.lo = k; a.hi = k + 1; mega<false><<<grid, 512, LDS_BYTES, stream>>>(a); }
#endif
}
```
